# Optimizing an MI355X kernel written in HIP

```python
import jax
import jax.numpy as jnp
from jax import lax
import numpy as np

D_MODEL = 1024
BATCH = 8
SEQ = 8192
DEPTH = 4

GRID_W = 64
CTX_LEN = 256
N_MIXERS = 3
N_ATTN_LAYERS = (DEPTH + 2) // N_MIXERS
N_POOL_LAYERS = (DEPTH + 1) // N_MIXERS
N_RET_LAYERS = DEPTH // N_MIXERS

ATTN_HEADS = 16
ATTN_KV_HEADS = 4
ATTN_GROUP = ATTN_HEADS // ATTN_KV_HEADS
HEAD_DIM = D_MODEL // ATTN_HEADS
WINDOW = 128
ATTN_BLOCK = 128
ROPE_BASE = 10000.0
NEG_INF = -1e30

POOL_WINDOWS = (2, 4, 8, 16)
POOL_GROUPS = len(POOL_WINDOWS)
POOL_GROUP_DIM = D_MODEL // POOL_GROUPS

RET_HEADS = 4
RET_DK = D_MODEL // RET_HEADS
RET_DV = 2 * RET_DK
RET_CHUNK = 128
RET_BWD_OFFSET = 0.5

FFN_HIDDEN = ((8 * D_MODEL + 3 * 256 - 1) // (3 * 256)) * 256
NORM_EPS = 1e-6

kernel_name = 'hybrid_interleaved_dit_block'


def rmsnorm(x, gain=None):
    xf = x.astype(jnp.float32)
    y = xf * lax.rsqrt(jnp.mean(xf * xf, axis=-1, keepdims=True) + NORM_EPS)
    if gain is not None:
        y = y * gain.astype(jnp.float32)
    return y.astype(x.dtype)


def pre_norm(xs, gain, shift, scale):
    return rmsnorm(xs, gain) * (1 + scale) + shift


def apply_rotary(x, cos, sin):
    half = x.shape[-1] // 2
    shape = (1, x.shape[1]) + (1,) * (x.ndim - 3) + (half,)
    cos = cos.reshape(shape).astype(x.dtype)
    sin = sin.reshape(shape).astype(x.dtype)
    x1, x2 = x[..., :half], x[..., half:]
    return jnp.concatenate([x1 * cos - x2 * sin, x2 * cos + x1 * sin], axis=-1)


def axial_rotary_tables(n_tokens):
    rows = n_tokens // GRID_W
    row = jnp.repeat(jnp.arange(rows, dtype=jnp.float32), GRID_W)
    col = jnp.tile(jnp.arange(GRID_W, dtype=jnp.float32), rows)
    n_freq = HEAD_DIM // 4
    inv = ROPE_BASE ** (-jnp.arange(n_freq, dtype=jnp.float32) / n_freq)
    ang = jnp.concatenate([row[:, None] * inv, col[:, None] * inv], axis=-1)
    return jnp.cos(ang), jnp.sin(ang)


def retention_rotary_tables(n_tokens):
    inv = ROPE_BASE ** (-jnp.linspace(0.0, 1.0, RET_DK // 2, dtype=jnp.float32))
    ang = jnp.arange(n_tokens, dtype=jnp.float32)[:, None] * inv
    return jnp.cos(ang), jnp.sin(ang)


def softmax_with_sink(logits, sink):
    full = jnp.concatenate([logits, jnp.broadcast_to(sink, logits.shape[:-1] + (1,))], axis=-1)
    return jax.nn.softmax(full, axis=-1)[..., :-1]


def banded_window_attention(q, k, v, k_ctx, v_ctx, sink):
    B, T = q.shape[:2]
    n_blk = T // ATTN_BLOCK
    span = 3 * ATTN_BLOCK
    pad = ((0, 0), (ATTN_BLOCK, ATTN_BLOCK), (0, 0), (0, 0))
    kp = jnp.pad(k, pad)
    vp = jnp.pad(v, pad)
    offs = jnp.arange(span) - ATTN_BLOCK
    rel = offs[None, :] - jnp.arange(ATTN_BLOCK)[:, None]
    near = jnp.abs(rel) <= WINDOW
    q_blocks = jnp.moveaxis(q.reshape((B, n_blk, ATTN_BLOCK) + q.shape[2:]), 1, 0)

    def one_block(args):
        qb, i = args
        start = i * ATTN_BLOCK
        kb = lax.dynamic_slice_in_dim(kp, start, span, axis=1)
        vb = lax.dynamic_slice_in_dim(vp, start, span, axis=1)
        key_pos = start + offs
        valid = near & ((key_pos >= 0) & (key_pos < T))[None, :]
        s_loc = jnp.einsum('bqkgd,bskd->bkgqs', qb, kb).astype(jnp.float32)
        s_loc = jnp.where(valid, s_loc, NEG_INF)
        s_ctx = jnp.einsum('bqkgd,bskd->bkgqs', qb, k_ctx).astype(jnp.float32)
        p = softmax_with_sink(jnp.concatenate([s_loc, s_ctx], axis=-1), sink).astype(v.dtype)
        return (jnp.einsum('bkgqs,bskd->bqkgd', p[..., :span], vb)
                + jnp.einsum('bkgqs,bskd->bqkgd', p[..., span:], v_ctx))

    out = lax.map(one_block, (q_blocks, jnp.arange(n_blk)))
    return jnp.moveaxis(out, 0, 1).reshape(B, T, ATTN_HEADS * HEAD_DIM)


def attention_mixer(h_ctx, h_lat, w_qkv, w_o, q_gain, k_gain, sink, need_ctx_out):
    q_cols = ATTN_HEADS * HEAD_DIM
    scale = HEAD_DIM ** -0.5
    sink_logit = sink.astype(jnp.float32).reshape(ATTN_KV_HEADS, ATTN_GROUP, 1, 1)

    def heads_q(q):
        B, T, _ = q.shape
        return rmsnorm(q.reshape(B, T, ATTN_KV_HEADS, ATTN_GROUP, HEAD_DIM), q_gain) * scale

    def heads_kv(kv):
        B, T, _ = kv.shape
        k, v = jnp.split(kv, 2, axis=-1)
        return (rmsnorm(k.reshape(B, T, ATTN_KV_HEADS, HEAD_DIM), k_gain),
                v.reshape(B, T, ATTN_KV_HEADS, HEAD_DIM))

    B, T, _ = h_lat.shape
    cos, sin = axial_rotary_tables(T)
    qkv = h_lat @ w_qkv
    q_l = apply_rotary(heads_q(qkv[..., :q_cols]), cos, sin)
    k_l, v_l = heads_kv(qkv[..., q_cols:])
    k_l = apply_rotary(k_l, cos, sin)
    if need_ctx_out:
        qkv_c = h_ctx @ w_qkv
        q_c = heads_q(qkv_c[..., :q_cols])
        k_c, v_c = heads_kv(qkv_c[..., q_cols:])
    else:
        k_c, v_c = heads_kv(h_ctx @ w_qkv[:, q_cols:])
    y_l = banded_window_attention(q_l, k_l, v_l, k_c, v_c, sink_logit) @ w_o
    if not need_ctx_out:
        return None, y_l
    L = h_ctx.shape[1]
    s = jnp.einsum('bqkgd,bskd->bkgqs', q_c, k_c).astype(jnp.float32)
    p = softmax_with_sink(s, sink_logit).astype(v_c.dtype)
    y_c = jnp.einsum('bkgqs,bskd->bqkgd', p, v_c).reshape(B, L, q_cols) @ w_o
    return y_c, y_l


def window_means(h, window):
    T = h.shape[1]
    cs = jnp.pad(jnp.cumsum(h.astype(jnp.float32), axis=1), ((0, 0), (1, 0), (0, 0)))
    t = jnp.arange(T)
    lo = jnp.maximum(t - window // 2, 0)
    hi = jnp.minimum(t + window // 2, T)
    s = jnp.take(cs, hi, axis=1) - jnp.take(cs, lo, axis=1)
    return (s / (hi - lo).astype(jnp.float32)[None, :, None]).astype(h.dtype)


def pool_mixer(h, w_group, layer_scale):
    B, T, _ = h.shape
    groups = jnp.split(h, POOL_GROUPS, axis=-1)
    pooled = jnp.stack([window_means(g, w) - g for g, w in zip(groups, POOL_WINDOWS)], axis=2)
    y = jnp.einsum('btgc,gcd->btgd', pooled, w_group).reshape(B, T, D_MODEL)
    return y * layer_scale


def retention_chunked(q, k, v, log_g, state):
    B, T, H, _ = q.shape
    dv = v.shape[-1]
    n = T // RET_CHUNK

    def to_chunks(a):
        return jnp.moveaxis(a.reshape(B, n, RET_CHUNK, H, a.shape[-1]), 1, 0)

    pos = jnp.arange(RET_CHUNK, dtype=jnp.float32)
    diff = pos[:, None] - pos[None, :]
    intra = jnp.where(diff >= 0, jnp.exp(jnp.maximum(diff, 0.0)[None] * log_g[:, None, None]), 0.0)
    q_dec = jnp.exp((pos[:, None] + 1.0) * log_g[None, :])[None, :, :, None]
    k_dec = jnp.exp((RET_CHUNK - 1.0 - pos)[:, None] * log_g[None, :])[None, :, :, None]
    chunk_dec = jnp.exp(RET_CHUNK * log_g)[None, :, None, None]

    def step(s, blk):
        qc, kc, vc = blk
        scores = jnp.einsum('bihd,bjhd->bhij', qc, kc) * intra
        y = (jnp.einsum('bhij,bjhv->bihv', scores, vc)
             + jnp.einsum('bihd,bhdv->bihv', qc, s) * q_dec)
        s = s * chunk_dec + jnp.einsum('bjhd,bjhv->bhdv', kc * k_dec, vc)
        return s, y

    state, ys = lax.scan(step, state, (to_chunks(q), to_chunks(k), to_chunks(v)))
    return jnp.moveaxis(ys, 0, 1).reshape(B, T, H, dv), state


def retention_mixer(h_ctx, h_lat, w_in, w_o, need_ctx_out):
    hk = RET_HEADS * RET_DK
    hv = RET_HEADS * RET_DV
    qkv_cols = 2 * hk + hv
    heads = jnp.arange(RET_HEADS, dtype=jnp.float32)
    log_g_f = jnp.log1p(-jnp.exp2(-5.0 - heads))
    log_g_b = jnp.log1p(-jnp.exp2(-5.0 - RET_BWD_OFFSET - heads))

    def project_qkv(h, rotate):
        B, T, _ = h.shape
        qkv = h @ w_in[:, :qkv_cols]
        q = qkv[..., :hk].reshape(B, T, RET_HEADS, RET_DK)
        k = qkv[..., hk:2 * hk].reshape(B, T, RET_HEADS, RET_DK) * (RET_DK ** -0.5)
        v = qkv[..., 2 * hk:].reshape(B, T, RET_HEADS, RET_DV)
        if rotate:
            cos, sin = retention_rotary_tables(T)
            q = apply_rotary(q, cos, sin)
            k = apply_rotary(k, cos, sin)
        return q, k, v

    def combine(h, y_f, y_b):
        B, T, _ = h.shape
        g_f, g_b = jnp.split(h @ w_in[:, qkv_cols:], 2, axis=-1)
        y = (jax.nn.silu(g_f) * rmsnorm(y_f).reshape(B, T, hv).astype(h.dtype)
             + jax.nn.silu(g_b) * rmsnorm(y_b).reshape(B, T, hv).astype(h.dtype))
        return y @ w_o

    def flip(a):
        return jnp.flip(a, axis=1)

    B = h_lat.shape[0]
    zeros = jnp.zeros((B, RET_HEADS, RET_DK, RET_DV), jnp.float32)
    q_c, k_c, v_c = project_qkv(h_ctx, rotate=False)
    yc_f, s_f = retention_chunked(q_c, k_c, v_c, log_g_f, zeros)
    yc_b, s_b = retention_chunked(flip(q_c), flip(k_c), flip(v_c), log_g_b, zeros)
    q_l, k_l, v_l = project_qkv(h_lat, rotate=True)
    yl_f, _ = retention_chunked(q_l, k_l, v_l, log_g_f, s_f)
    yl_b, _ = retention_chunked(flip(q_l), flip(k_l), flip(v_l), log_g_b, s_b)
    y_l = combine(h_lat, yl_f, flip(yl_b))
    y_c = combine(h_ctx, yc_f, flip(yc_b)) if need_ctx_out else None
    return y_c, y_l


def swiglu(h, w_gate, w_up, w_down):
    return (jax.nn.silu(h @ w_gate) * (h @ w_up)) @ w_down


def setup_inputs(seed: int = 0) -> dict:
    key = jax.random.key(seed)
    ks = jax.random.split(key, 20)

    def nrm(k, shape, scale):
        return jax.random.normal(k, shape, jnp.float32) * scale

    qkv_cols = (ATTN_HEADS + 2 * ATTN_KV_HEADS) * HEAD_DIM
    ret_cols = 2 * RET_HEADS * RET_DK + 3 * RET_HEADS * RET_DV
    return {
        'x': nrm(ks[0], (BATCH, SEQ, D_MODEL), 1.0),
        'c': nrm(ks[1], (BATCH, D_MODEL), 1.0),
        'ctx': nrm(ks[2], (BATCH, CTX_LEN, D_MODEL), 1.0),
        'c_ctx': nrm(ks[3], (D_MODEL,), 1.0),
        'ada_w': nrm(ks[4], (DEPTH, D_MODEL, 6 * D_MODEL), 0.5 * D_MODEL ** -0.5),
        'ada_b': nrm(ks[5], (DEPTH, 6 * D_MODEL), 0.02),
        'norm_mix': 1.0 + nrm(ks[6], (DEPTH, D_MODEL), 0.1),
        'norm_ffn': 1.0 + nrm(ks[7], (DEPTH, D_MODEL), 0.1),
        'attn_w_qkv': nrm(ks[8], (N_ATTN_LAYERS, D_MODEL, qkv_cols), D_MODEL ** -0.5),
        'attn_w_o': nrm(ks[9], (N_ATTN_LAYERS, ATTN_HEADS * HEAD_DIM, D_MODEL), (ATTN_HEADS * HEAD_DIM) ** -0.5),
        'attn_q_norm': 1.0 + nrm(ks[10], (N_ATTN_LAYERS, HEAD_DIM), 0.1),
        'attn_k_norm': 1.0 + nrm(ks[11], (N_ATTN_LAYERS, HEAD_DIM), 0.1),
        'attn_sink': nrm(ks[12], (N_ATTN_LAYERS, ATTN_HEADS), 1.0),
        'pool_w': nrm(ks[13], (N_POOL_LAYERS, POOL_GROUPS, POOL_GROUP_DIM, POOL_GROUP_DIM), POOL_GROUP_DIM ** -0.5),
        'pool_scale': 1.0 + nrm(ks[14], (N_POOL_LAYERS, D_MODEL), 0.1),
        'ret_w_in': nrm(ks[15], (N_RET_LAYERS, D_MODEL, ret_cols), D_MODEL ** -0.5),
        'ret_w_o': nrm(ks[16], (N_RET_LAYERS, RET_HEADS * RET_DV, D_MODEL), (RET_HEADS * RET_DV) ** -0.5),
        'ffn_w_gate': nrm(ks[17], (DEPTH, D_MODEL, FFN_HIDDEN), D_MODEL ** -0.5),
        'ffn_w_up': nrm(ks[18], (DEPTH, D_MODEL, FFN_HIDDEN), D_MODEL ** -0.5),
        'ffn_w_down': nrm(ks[19], (DEPTH, FFN_HIDDEN, D_MODEL), FFN_HIDDEN ** -0.5),
    }


def reference(x, c, ctx, c_ctx, ada_w, ada_b, norm_mix, norm_ffn, attn_w_qkv, attn_w_o, attn_q_norm,
              attn_k_norm, attn_sink, pool_w, pool_scale, ret_w_in, ret_w_o, ffn_w_gate, ffn_w_up, ffn_w_down):
    x_lat, x_ctx = x, ctx
    cond_lat = jax.nn.silu(c)[:, None, :]
    cond_ctx = jax.nn.silu(c_ctx)[None, None, :]
    for i in range(DEPTH):
        kind, slot = i % N_MIXERS, i // N_MIXERS
        need_ctx_out = i < DEPTH - 1
        sh_m, sc_m, g_m, sh_f, sc_f, g_f = jnp.split(cond_lat @ ada_w[i] + ada_b[i], 6, axis=-1)
        h_l = pre_norm(x_lat, norm_mix[i], sh_m, sc_m)
        if need_ctx_out or kind != 1:
            csh_m, csc_m, cg_m, csh_f, csc_f, cg_f = jnp.split(cond_ctx @ ada_w[i] + ada_b[i], 6, axis=-1)
            h_c = pre_norm(x_ctx, norm_mix[i], csh_m, csc_m)
        if kind == 0:
            y_c, y_l = attention_mixer(h_c, h_l, attn_w_qkv[slot], attn_w_o[slot], attn_q_norm[slot],
                                       attn_k_norm[slot], attn_sink[slot], need_ctx_out)
        elif kind == 1:
            y_l = pool_mixer(h_l, pool_w[slot], pool_scale[slot])
            y_c = pool_mixer(h_c, pool_w[slot], pool_scale[slot]) if need_ctx_out else None
        else:
            y_c, y_l = retention_mixer(h_c, h_l, ret_w_in[slot], ret_w_o[slot], need_ctx_out)
        x_lat = x_lat + g_m * y_l
        x_lat = x_lat + g_f * swiglu(pre_norm(x_lat, norm_ffn[i], sh_f, sc_f),
                                     ffn_w_gate[i], ffn_w_up[i], ffn_w_down[i])
        if need_ctx_out:
            x_ctx = x_ctx + cg_m * y_c
            x_ctx = x_ctx + cg_f * swiglu(pre_norm(x_ctx, norm_ffn[i], csh_f, csc_f),
                                          ffn_w_gate[i], ffn_w_up[i], ffn_w_down[i])
    return x_lat
```

```cpp
#include <hip/hip_runtime.h>
#include <hip/hip_cooperative_groups.h>
#include <cstdio>
#include <cstdint>
namespace cg = cooperative_groups;

#define DI __device__ __forceinline__
#define LAS __attribute__((address_space(3)))
typedef unsigned short bf16_t;
typedef short bf16x8 __attribute__((ext_vector_type(8)));
typedef short s16x4 __attribute__((ext_vector_type(4)));
typedef float f32x4 __attribute__((ext_vector_type(4)));
typedef float f32x16 __attribute__((ext_vector_type(16)));
typedef unsigned u32x4 __attribute__((ext_vector_type(4)));
typedef unsigned u32x2 __attribute__((ext_vector_type(2)));
typedef float f32x2_t __attribute__((ext_vector_type(2)));
typedef __bf16 bf16x2_t __attribute__((ext_vector_type(2)));
typedef short v4i16_t __attribute__((ext_vector_type(4)));

DI unsigned pk2(float lo, float hi) { f32x2_t v = {lo, hi}; bf16x2_t b = __builtin_convertvector(v, bf16x2_t); return __builtin_bit_cast(unsigned, b); }
DI float bflo(unsigned w) { return __uint_as_float(w << 16); }
DI float bfhi(unsigned w) { return __uint_as_float(w & 0xffff0000u); }
DI float silu_f(float x) { return x * __builtin_amdgcn_rcpf(1.0f + __expf(-x)); }
DI int crow(int reg, int h) { return (reg & 3) + 8 * (reg >> 2) + 4 * h; }
DI float shx(float v, int m, int lane) { return __int_as_float(__builtin_amdgcn_ds_bpermute((lane ^ m) << 2, __float_as_int(v))); }
DI float wave_sum(float v, int lane) {
#pragma unroll
    for (int o = 1; o < 64; o <<= 1) v += shx(v, o, lane);
    return v;
}
DI int opaque_tid(int wid0) { int l; asm volatile("v_mbcnt_lo_u32_b32 %0, -1, 0\n\tv_mbcnt_hi_u32_b32 %0, -1, %0" : "=v"(l)); return wid0 * 64 + l; }
DI int opq(int v) { asm volatile("" : "+v"(v)); return v; }
#define MFMA32(a, b, c) __builtin_amdgcn_mfma_f32_32x32x16_bf16((a), (b), (c), 0, 0, 0)
DI s16x4 trd(const LAS unsigned char* p) { return __builtin_bit_cast(s16x4, __builtin_amdgcn_ds_read_tr16_b64_v4i16((LAS v4i16_t*)p)); }
DI bf16x8 cat8(s16x4 lo, s16x4 hi) { return __builtin_shufflevector(lo, hi, 0, 1, 2, 3, 4, 5, 6, 7); }
DI bf16x8 pack8(const f32x16& x, int s) {
    u32x4 p; p.x = pk2(x[8 * s], x[8 * s + 1]); p.y = pk2(x[8 * s + 2], x[8 * s + 3]); p.z = pk2(x[8 * s + 4], x[8 * s + 5]); p.w = pk2(x[8 * s + 6], x[8 * s + 7]);
    return __builtin_bit_cast(bf16x8, p);
}

constexpr int DM = 1024, NB = 8, SEQ = 8192, CTXL = 256, FFH = 2816;
constexpr int MLAT = NB * SEQ, MCTX = NB * CTXL, MTOT = MLAT + MCTX;
constexpr int NTILE_M = MTOT / 256;
constexpr int MODW = 6 * DM;
constexpr int MHALF = 4 * SEQ + 4 * CTXL;
constexpr float NEPS = 1e-6f;

constexpr size_t MiB = 1u << 20;
constexpr size_t WS_MOD = 0;
constexpr size_t WS_ROPEA = 1 * MiB;
constexpr size_t WS_ROPER = 3 * MiB;
constexpr size_t WS_XC = 11 * MiB;
constexpr size_t WS_SS = 19 * MiB;
constexpr size_t WS_WQKV = 36 * MiB;
constexpr size_t WS_WAO = 42 * MiB;
constexpr size_t WS_WP = 46 * MiB;
constexpr size_t WS_WIN = 47 * MiB;
constexpr size_t WS_WRO = 63 * MiB;
constexpr size_t WS_WGU = 67 * MiB;
constexpr size_t WS_WD = 111 * MiB;
constexpr size_t WS_H = 133 * MiB;
constexpr size_t WS_BIG = 265 * MiB;
constexpr size_t WS_QKV = WS_BIG;
constexpr size_t WS_AO = WS_BIG + 198 * MiB;
constexpr size_t WS_HID = WS_BIG;
constexpr size_t WS_POOLED = WS_BIG;
constexpr size_t WS_RQKV = WS_BIG;
constexpr size_t WS_YF = WS_BIG + 264 * MiB;
constexpr size_t WS_YB = WS_BIG + 396 * MiB;
constexpr size_t WS_Z = WS_BIG + 528 * MiB;
constexpr size_t WS_END = WS_BIG + 660 * MiB;

constexpr int LDS_BYTES = 147456;

namespace pg8 {
constexpr int BM = 256, BK = 64, HALF = 128, HTB = HALF * BK * 2, STAGE_BYTES = 8 * HTB, NXCD = 8, WGM = 8;
DI int lds_byte(int r, int c) { const int st = (r >> 4) * 2 + (c >> 5), rr = r & 15, cc = c & 31, ob = rr * 64 + cc * 2; return st * 1024 + (ob ^ (((ob >> 9) & 1) << 5)); }
DI void stage_rc(int b, int& R, int& C) { const int st = b / 1024, sb = b % 1024, swz = sb ^ (((sb >> 9) & 1) << 5); R = (st >> 1) * 16 + swz / 64; C = (st & 1) * 32 + (swz % 64) / 2; }
DI int perm32(int rho) { const int n = rho >> 4, i = rho & 15; return 8 * (i >> 2) + 4 * n + (i & 3); }

struct Unit { int pm, pn, lt; };
struct Gemm { const bf16_t* A; const bf16_t* Bt; int lda, ldb, K; int a_local; int grouped; };

struct Sched {
    int nM, nN, nwg, G, c, s0n, s0b, s1b;
    DI void init(int nM_, int nN_, int G_, int c_, int s0n_, int s0b_, int s1b_) { nM = nM_; nN = nN_; nwg = nM * nN; G = G_; c = c_; s0n = s0n_; s0b = s0b_; s1b = s1b_; }
    DI bool next(int i, Unit& u) const {
        const long L = (long)i * G + c; if (L >= nwg) return false;
        int wgid = (int)L; { const int q = nwg / NXCD, r = nwg % NXCD, xcd = wgid % NXCD, off = wgid / NXCD; wgid = (xcd < r ? xcd * (q + 1) : r * (q + 1) + (xcd - r) * q) + off; }
        const int nig = WGM * nN, gid = wgid / nig, fm = gid * WGM, gsz = (nM - fm) < WGM ? (nM - fm) : WGM;
        const int t = fm + ((wgid % nig) % gsz); u.pn = (wgid % nig) / gsz; u.lt = t; u.pm = t < s0n ? s0b + t : s1b + (t - s0n); return true;
    }
};

template <class Epi>
DI void gemm_phase(LAS unsigned char* lds, const Gemm g, const Sched& S, const Epi& E, int wid0) {
    const int tid = opaque_tid(wid0), wid = __builtin_amdgcn_readfirstlane(tid >> 6), lane = tid & 63, wr = wid >> 2, wc = wid & 3, fr = lane & 15, fq = lane >> 4;
    const int K = g.K, nt = K / BK;
    unsigned voffA[2], voffB[2];
#pragma unroll
    for (int i = 0; i < 2; ++i) { int R, C; stage_rc(tid * 16 + i * 8192, R, C); const int Rb = Epi::PERM ? ((R & ~31) + perm32(R & 31)) : R;
        voffA[i] = (unsigned)(R * g.lda + C) * 2u; voffB[i] = (unsigned)(Rb * g.ldb + C) * 2u; }
    const size_t kstep = (size_t)(BK * 2);
    const size_t hstepA = (size_t)HALF * g.lda * 2, hstepB = (size_t)HALF * g.ldb * 2;
    const size_t tstepA = 2 * hstepA, tstepB = 2 * hstepB;
    const unsigned ldsw = (unsigned)wid * 1024u;
    const int aoff = lds_byte(wr * 64 + fr, fq * 8), boff = lds_byte(wc * 32 + fr, fq * 8);
#define PG8_SA(b, h) (((b) * 2 + (h)) * HTB)
#define PG8_SB(b, h) ((4 + (b) * 2 + (h)) * HTB)
#define PG8_STAGE(bufoff, gbase, voff) do { _Pragma("unroll") for (int _i = 0; _i < 2; ++_i) \
        __builtin_amdgcn_global_load_lds((const unsigned*)((const char*)(gbase) + (voff)[_i]), (LAS unsigned*)(lds + (bufoff) + ldsw + _i * 8192), 16, 0, 0); } while (0)
#define PG8_LDA(dst, b, h) do { _Pragma("unroll") for (int m = 0; m < 4; ++m) _Pragma("unroll") for (int k = 0; k < 2; ++k) dst[m][k] = *(const LAS bf16x8*)(lds + PG8_SA(b, h) + aoff + m * 2048 + k * 1024); } while (0)
#define PG8_LDB(dst, b, h) do { _Pragma("unroll") for (int n = 0; n < 2; ++n) _Pragma("unroll") for (int k = 0; k < 2; ++k) dst[n][k] = *(const LAS bf16x8*)(lds + PG8_SB(b, h) + boff + n * 2048 + k * 1024); } while (0)
#define PG8_MMA(ai, bj, At, Bt) do { __builtin_amdgcn_s_setprio(1); _Pragma("unroll") for (int m = 0; m < 4; ++m) _Pragma("unroll") for (int n = 0; n < 2; ++n) _Pragma("unroll") for (int k = 0; k < 2; ++k) \
        acc[ai][bj][m][n] = __builtin_amdgcn_mfma_f32_16x16x32_bf16(Bt[n][k], At[m][k], acc[ai][bj][m][n], 0, 0, 0); __builtin_amdgcn_s_setprio(0); } while (0)
#define PG8_WAIT_V(n) asm volatile("s_waitcnt vmcnt(" #n ")" ::: "memory")
#define PG8_WAIT_L(n) asm volatile("s_waitcnt lgkmcnt(" #n ")" ::: "memory")
#define PG8_BAR __builtin_amdgcn_s_barrier()
#define PG8_SCHED __builtin_amdgcn_sched_barrier(0)
#define PG8_APTR(u) ((const char*)g.A + (size_t)(g.a_local ? (u).lt : (u).pm) * tstepA + (g.grouped ? (size_t)(u).pn * K * 2 : (size_t)0))
#define PG8_BPTR(u) ((const char*)g.Bt + (size_t)(u).pn * tstepB)
    Unit cur, nxt; int ui = 0;
    if (!S.next(0, cur)) return;
    f32x4 acc[2][2][4][2];
#pragma unroll
    for (int a = 0; a < 2; ++a)
#pragma unroll
        for (int b = 0; b < 2; ++b)
#pragma unroll
            for (int m = 0; m < 4; ++m)
#pragma unroll
                for (int n = 0; n < 2; ++n) acc[a][b][m][n] = (f32x4){0.f, 0.f, 0.f, 0.f};
    bf16x8 At[4][2], B0[2][2], B1[2][2];
    const char* cA = PG8_APTR(cur); const char* cB = PG8_BPTR(cur);
    PG8_STAGE(PG8_SB(0, 0), cB, voffB); PG8_STAGE(PG8_SB(0, 1), cB + hstepB, voffB); PG8_STAGE(PG8_SA(0, 0), cA, voffA); PG8_STAGE(PG8_SA(0, 1), cA + hstepA, voffA);
    if (wr == 1) PG8_BAR;
    PG8_WAIT_V(2); PG8_BAR;
    PG8_STAGE(PG8_SB(1, 0), cB + kstep, voffB); PG8_STAGE(PG8_SA(1, 0), cA + kstep, voffA); PG8_STAGE(PG8_SB(1, 1), cB + hstepB + kstep, voffB);
    PG8_WAIT_V(6); PG8_BAR;
    for (;;) {
        const bool has_next = S.next(ui + 1, nxt);
        const char* nA = has_next ? PG8_APTR(nxt) : cA; const char* nB = has_next ? PG8_BPTR(nxt) : cB;
        for (int t = 0; t < nt; t += 2) {
            const bool last = (t == nt - 2);
            const char* a1 = cA + (size_t)(t + 1) * kstep;
            const char* a2 = last ? nA : cA + (size_t)(t + 2) * kstep; const char* b2 = last ? nB : cB + (size_t)(t + 2) * kstep;
            const char* a3 = a2 + kstep; const char* b3 = b2 + kstep;
            PG8_LDB(B0, 0, 0); PG8_LDB(B1, 0, 1); PG8_SCHED; PG8_LDA(At, 0, 0); PG8_STAGE(PG8_SA(1, 1), a1 + hstepA, voffA);
            PG8_WAIT_V(8); PG8_WAIT_L(0); PG8_BAR; PG8_MMA(0, 0, At, B0); PG8_MMA(0, 1, At, B1); PG8_BAR; PG8_SCHED;
            PG8_LDA(At, 0, 1); PG8_STAGE(PG8_SB(0, 0), b2, voffB); PG8_STAGE(PG8_SB(0, 1), b2 + hstepB, voffB); PG8_STAGE(PG8_SA(0, 0), a2, voffA);
            PG8_WAIT_V(8); PG8_WAIT_L(0); PG8_BAR; PG8_MMA(1, 0, At, B0); PG8_MMA(1, 1, At, B1); PG8_BAR; PG8_SCHED;
            PG8_LDB(B0, 1, 0); PG8_LDB(B1, 1, 1); PG8_SCHED; PG8_LDA(At, 1, 0); PG8_STAGE(PG8_SA(0, 1), a2 + hstepA, voffA);
            PG8_WAIT_V(8); PG8_WAIT_L(0); PG8_BAR; PG8_MMA(0, 0, At, B0); PG8_MMA(0, 1, At, B1); PG8_BAR; PG8_SCHED;
            PG8_LDA(At, 1, 1); PG8_STAGE(PG8_SB(1, 0), b3, voffB); PG8_STAGE(PG8_SB(1, 1), b3 + hstepB, voffB); PG8_STAGE(PG8_SA(1, 0), a3, voffA);
            PG8_WAIT_V(8); PG8_WAIT_L(0); PG8_BAR; PG8_MMA(1, 0, At, B0); PG8_MMA(1, 1, At, B1); PG8_BAR; PG8_SCHED;
        }
        if (wr == 0) PG8_BAR;
        E(acc, cur, wr, wc, fr, fq);
        if (!has_next) break;
#pragma unroll
        for (int a = 0; a < 2; ++a)
#pragma unroll
            for (int b = 0; b < 2; ++b)
#pragma unroll
                for (int m = 0; m < 4; ++m)
#pragma unroll
                    for (int n = 0; n < 2; ++n) acc[a][b][m][n] = (f32x4){0.f, 0.f, 0.f, 0.f};
        cur = nxt; cA = nA; cB = nB; ++ui;
        if (wr == 1) PG8_BAR;
    }
    PG8_WAIT_V(0);
    PG8_BAR;
#undef PG8_SA
#undef PG8_SB
#undef PG8_STAGE
#undef PG8_LDA
#undef PG8_LDB
#undef PG8_MMA
#undef PG8_WAIT_V
#undef PG8_WAIT_L
#undef PG8_BAR
#undef PG8_SCHED
#undef PG8_APTR
#undef PG8_BPTR
}

typedef f32x4 Acc[2][2][4][2];

struct EpiResid {
    static constexpr bool PERM = false;
    const float* base_l; const float* base_c; float* out_l; float* out_c; const float* gate; const float* colscale;
    DI void operator()(const Acc& acc, const Unit& u, int wr, int wc, int fr, int fq) const {
        const bool lat = u.pm < 256; const int bb = lat ? (u.pm >> 5) : 8;
        const size_t rowt = lat ? (size_t)u.pm * 256 : (size_t)(u.pm - 256) * 256;
        const float* bp = (lat ? base_l : base_c) + rowt * DM; float* op = (lat ? out_l : out_c) + rowt * DM;
        const float* gp = gate + bb * MODW;
        const int col0 = u.pn * 256 + wc * 32 + 4 * fq;
#pragma unroll
        for (int bj = 0; bj < 2; ++bj)
#pragma unroll
            for (int n = 0; n < 2; ++n) {
                const int c = col0 + bj * 128 + n * 16;
                f32x4 gv = *(const f32x4*)(gp + c);
                if (colscale) gv = gv * *(const f32x4*)(colscale + c);
#pragma unroll
                for (int ai = 0; ai < 2; ++ai) {
                    const int frx = opq(fr);
#pragma unroll
                    for (int m = 0; m < 4; ++m) {
                        const size_t off = (size_t)(ai * 128 + wr * 64 + m * 16 + frx) * DM + c;
                        const f32x4 o = *(const f32x4*)(bp + off) + acc[ai][bj][m][n] * gv;
                        *(f32x4*)(op + off) = o;
                    }
                    asm volatile("" ::: "memory");
                }
            }
    }
};

struct EpiSwiGLU {
    static constexpr bool PERM = true;
    bf16_t* HID;
    DI void operator()(const Acc& acc, const Unit& u, int wr, int wc, int fr, int fq) const {
        const int hc0 = u.pn * 128 + wc * 32 + 8 * fq;
#pragma unroll
        for (int ai = 0; ai < 2; ++ai)
#pragma unroll
            for (int m = 0; m < 4; ++m) {
                const f32x4 g0 = acc[ai][0][m][0], g1 = acc[ai][0][m][1], u0 = acc[ai][1][m][0], u1 = acc[ai][1][m][1];
                const size_t row0 = (size_t)u.pm * 256 + wr * 64 + opq(fr);
                u32x4 w;
                w.x = pk2(silu_f(g0[0]) * u0[0], silu_f(g0[1]) * u0[1]); w.y = pk2(silu_f(g0[2]) * u0[2], silu_f(g0[3]) * u0[3]);
                w.z = pk2(silu_f(g1[0]) * u1[0], silu_f(g1[1]) * u1[1]); w.w = pk2(silu_f(g1[2]) * u1[2], silu_f(g1[3]) * u1[3]);
                *(u32x4*)(HID + (row0 + ai * 128 + m * 16) * FFH + hc0) = w;
                asm volatile("" ::: "memory");
            }
    }
};

struct EpiAttnQKV {
    static constexpr bool PERM = true;
    bf16_t* QKV; const float* qg; const float* kg; const float* cosT; const float* sinT;
    DI void operator()(const Acc& acc, const Unit& u, int wr, int wc, int fr, int fq) const {
        const int mode = u.pn < 4 ? 0 : (u.pn == 4 ? 1 : 2);
        const bool lat = u.pm < 256; const int tok0 = (u.pm * 256) & (SEQ - 1);
        const int jb = 8 * fq;
        const float* gp = mode == 0 ? qg : kg;
        f32x4 gn[2][2];
#pragma unroll
        for (int bj = 0; bj < 2; ++bj)
#pragma unroll
            for (int n = 0; n < 2; ++n) gn[bj][n] = *(const f32x4*)(gp + 32 * bj + jb + 4 * n);
        const int outcol = (mode == 0 ? u.pn * 256 : (mode == 1 ? 1024 : 1280)) + wc * 64 + jb;
#pragma unroll
        for (int ai = 0; ai < 2; ++ai)
#pragma unroll
            for (int m = 0; m < 4; ++m) {
                const int rl = ai * 128 + wr * 64 + m * 16 + opq(fr);
                f32x4 v[2][2];
#pragma unroll
                for (int bj = 0; bj < 2; ++bj)
#pragma unroll
                    for (int n = 0; n < 2; ++n) v[bj][n] = acc[ai][bj][m][n];
                if (mode < 2) {
                    float ss = 0.f;
#pragma unroll
                    for (int bj = 0; bj < 2; ++bj)
#pragma unroll
                        for (int n = 0; n < 2; ++n) { const f32x4 x = v[bj][n]; ss += (x[0] * x[0] + x[1] * x[1]) + (x[2] * x[2] + x[3] * x[3]); }
                    { const int ln = fr + 16 * fq; ss += shx(ss, 16, ln); ss += shx(ss, 32, ln); }
                    float rs = rsqrtf(ss * (1.0f / 64.0f) + NEPS); if (mode == 0) rs *= 0.125f;
#pragma unroll
                    for (int bj = 0; bj < 2; ++bj)
#pragma unroll
                        for (int n = 0; n < 2; ++n) v[bj][n] = v[bj][n] * rs * gn[bj][n];
                    if (lat) {
                        const int t = tok0 + rl;
#pragma unroll
                        for (int n = 0; n < 2; ++n) {
                            const f32x4 cs = *(const f32x4*)(cosT + t * 32 + jb + 4 * n), sn = *(const f32x4*)(sinT + t * 32 + jb + 4 * n);
                            const f32x4 x1 = v[0][n], x2 = v[1][n];
                            v[0][n] = x1 * cs - x2 * sn; v[1][n] = x2 * cs + x1 * sn;
                        }
                    }
                }
                bf16_t* rp = QKV + ((size_t)u.pm * 256 + rl) * 1536 + outcol;
#pragma unroll
                for (int bj = 0; bj < 2; ++bj) {
                    u32x4 w; w.x = pk2(v[bj][0][0], v[bj][0][1]); w.y = pk2(v[bj][0][2], v[bj][0][3]); w.z = pk2(v[bj][1][0], v[bj][1][1]); w.w = pk2(v[bj][1][2], v[bj][1][3]);
                    *(u32x4*)(rp + 32 * bj) = w;
                }
                asm volatile("" ::: "memory");
            }
    }
};

struct EpiRetQKV {
    static constexpr bool PERM = true;
    bf16_t* RQKV; const float* cosT; const float* sinT;
    DI void operator()(const Acc& acc, const Unit& u, int wr, int wc, int fr, int fq) const {
        const bool lat = u.pm < 256; const int tok0 = (u.pm * 256) & (SEQ - 1);
        const int j0 = 32 * wc + 8 * fq;
        const float sc = (u.pn >= 4 && u.pn < 8) ? 0.0625f : 1.0f;
#pragma unroll
        for (int ai = 0; ai < 2; ++ai)
#pragma unroll
            for (int m = 0; m < 4; ++m) {
                const int rl = ai * 128 + wr * 64 + m * 16 + opq(fr);
                f32x4 v[2][2];
#pragma unroll
                for (int bj = 0; bj < 2; ++bj)
#pragma unroll
                    for (int n = 0; n < 2; ++n) v[bj][n] = acc[ai][bj][m][n] * sc;
                if (u.pn < 8 && lat) {
                    const int t = tok0 + rl;
#pragma unroll
                    for (int n = 0; n < 2; ++n) {
                        const f32x4 cs = *(const f32x4*)(cosT + t * 128 + j0 + 4 * n), sn = *(const f32x4*)(sinT + t * 128 + j0 + 4 * n);
                        const f32x4 x1 = v[0][n], x2 = v[1][n];
                        v[0][n] = x1 * cs - x2 * sn; v[1][n] = x2 * cs + x1 * sn;
                    }
                }
                bf16_t* rp = RQKV + ((size_t)u.lt * 256 + rl) * 4096 + u.pn * 256 + j0;
#pragma unroll
                for (int bj = 0; bj < 2; ++bj) {
                    u32x4 w; w.x = pk2(v[bj][0][0], v[bj][0][1]); w.y = pk2(v[bj][0][2], v[bj][0][3]); w.z = pk2(v[bj][1][0], v[bj][1][1]); w.w = pk2(v[bj][1][2], v[bj][1][3]);
                    *(u32x4*)(rp + 128 * bj) = w;
                }
                asm volatile("" ::: "memory");
            }
    }
};

struct EpiRetGate {
    static constexpr bool PERM = true;
    const bf16_t* YF; const bf16_t* YB; const float* SS; bf16_t* Z;
    DI void operator()(const Acc& acc, const Unit& u, int wr, int wc, int fr, int fq) const {
        const int c0 = u.pn * 128 + 32 * wc + 8 * fq, head = u.pn >> 2;
#pragma unroll
        for (int ai = 0; ai < 2; ++ai)
#pragma unroll
            for (int m = 0; m < 4; ++m) {
                const size_t lrow = (size_t)u.lt * 256 + ai * 128 + wr * 64 + m * 16 + opq(fr);
                const float* sp = SS + ((lrow * 4 + head) * 2) * 16;
                float sf = 0.f, sb = 0.f;
#pragma unroll
                for (int q = 0; q < 4; ++q) { const f32x4 a = *(const f32x4*)(sp + 4 * q), b = *(const f32x4*)(sp + 16 + 4 * q); sf += (a[0] + a[1]) + (a[2] + a[3]); sb += (b[0] + b[1]) + (b[2] + b[3]); }
                const float rf = rsqrtf(sf * (1.0f / 512.0f) + NEPS), rb = rsqrtf(sb * (1.0f / 512.0f) + NEPS);
                const u32x4 yf = *(const u32x4*)(YF + lrow * 2048 + c0), yb = *(const u32x4*)(YB + lrow * 2048 + c0);
                const f32x4 f0 = acc[ai][0][m][0], f1 = acc[ai][0][m][1], b0 = acc[ai][1][m][0], b1 = acc[ai][1][m][1];
                u32x4 w;
                w.x = pk2(silu_f(f0[0]) * bflo(yf.x) * rf + silu_f(b0[0]) * bflo(yb.x) * rb, silu_f(f0[1]) * bfhi(yf.x) * rf + silu_f(b0[1]) * bfhi(yb.x) * rb);
                w.y = pk2(silu_f(f0[2]) * bflo(yf.y) * rf + silu_f(b0[2]) * bflo(yb.y) * rb, silu_f(f0[3]) * bfhi(yf.y) * rf + silu_f(b0[3]) * bfhi(yb.y) * rb);
                w.z = pk2(silu_f(f1[0]) * bflo(yf.z) * rf + silu_f(b1[0]) * bflo(yb.z) * rb, silu_f(f1[1]) * bfhi(yf.z) * rf + silu_f(b1[1]) * bfhi(yb.z) * rb);
                w.w = pk2(silu_f(f1[2]) * bflo(yf.w) * rf + silu_f(b1[2]) * bflo(yb.w) * rb, silu_f(f1[3]) * bfhi(yf.w) * rf + silu_f(b1[3]) * bfhi(yb.w) * rb);
                *(u32x4*)(Z + lrow * 2048 + c0) = w;
                asm volatile("" ::: "memory");
            }
    }
};
}

struct Params {
    const float* x; const float* c; const float* ctx; const float* c_ctx; const float* ada_w; const float* ada_b; const float* norm_mix; const float* norm_ffn;
    const float* attn_w_qkv; const float* attn_w_o; const float* attn_q_norm; const float* attn_k_norm; const float* attn_sink;
    const float* pool_w; const float* pool_scale; const float* ret_w_in; const float* ret_w_o; const float* ffn_w_gate; const float* ffn_w_up; const float* ffn_w_down;
    float* out; unsigned char* ws;
};

DI void transpose_item(const float* W, int ldw, int k0, int col0, bf16_t* dst, int ldd, int drow0, LAS float* scr, int lane) {
#pragma unroll 8
    for (int i = 0; i < 32; ++i) { const int kk = 2 * i + (lane >> 5); scr[kk * 33 + (lane & 31)] = W[(size_t)(k0 + kk) * ldw + col0 + (lane & 31)]; }
    asm volatile("s_waitcnt lgkmcnt(0)" ::: "memory");
    const int c = lane & 7;
#pragma unroll
    for (int j = 0; j < 4; ++j) { const int n = (lane >> 3) + 8 * j; const LAS float* s = scr + (8 * c) * 33 + n;
        u32x4 o; o.x = pk2(s[0 * 33], s[1 * 33]); o.y = pk2(s[2 * 33], s[3 * 33]); o.z = pk2(s[4 * 33], s[5 * 33]); o.w = pk2(s[6 * 33], s[7 * 33]);
        *(u32x4*)(dst + (size_t)(drow0 + n) * ldd + k0 + 8 * c) = o; }
    asm volatile("s_waitcnt lgkmcnt(0)" ::: "memory");
}
DI int dst_row_of(int kind, int n0) {
    if (kind == 0) return n0;
    if (kind == 1) return (n0 & ~255) + 128 * ((n0 >> 5) & 1) + 32 * ((n0 >> 6) & 3);
    return 256 * (n0 >> 7) + (n0 & 127) + (kind == 3 ? 128 : 0);
}
DI void transpose_matrix(const float* W, int K, int ldw, int col_off, int ncols, bf16_t* dst, int ldd, int drow_off, int kind, LAS float* scr, int lane, int gw, int NGW, int& cnt) {
    const int nblk = ncols / 32, nitems = (K / 64) * nblk;
    int first = (gw - (cnt % NGW) + NGW) % NGW;
    for (int it = first; it < nitems; it += NGW) {
        const int kb = it / nblk, nb = it % nblk;
        transpose_item(W, ldw, 64 * kb, col_off + 32 * nb, dst, ldd, drow_off + dst_row_of(kind, 32 * nb), scr, lane);
    }
    cnt += nitems;
}

DI void prenorm_phase(const float* xl, const float* xc, const float* gain, const float* modl, int shi, int sci, bf16_t* H, int G, int bid, int wid0) {
    const int tid = opaque_tid(wid0), lane = tid & 63, gw = bid * 8 + __builtin_amdgcn_readfirstlane(tid >> 6), NGW = G * 8;
    for (int row = gw; row < MTOT; row += NGW) {
        const bool lat = row < MLAT; const int bb = lat ? (row >> 13) : 8;
        const float* src = lat ? xl + (size_t)row * DM : xc + (size_t)(row - MLAT) * DM;
        const float* mp = modl + bb * MODW;
        f32x4 v[4]; float s = 0.f;
#pragma unroll
        for (int j = 0; j < 4; ++j) { v[j] = *(const f32x4*)(src + 256 * j + 4 * lane); s += (v[j][0] * v[j][0] + v[j][1] * v[j][1]) + (v[j][2] * v[j][2] + v[j][3] * v[j][3]); }
        const float rstd = rsqrtf(wave_sum(s, lane) * (1.0f / DM) + NEPS);
#pragma unroll
        for (int j = 0; j < 4; ++j) {
            const int col = 256 * j + 4 * lane;
            const f32x4 g = *(const f32x4*)(gain + col), sc = *(const f32x4*)(mp + sci * DM + col), sh = *(const f32x4*)(mp + shi * DM + col);
            const f32x4 o = v[j] * rstd * g * (sc + 1.0f) + sh;
            u32x2 w; w.x = pk2(o[0], o[1]); w.y = pk2(o[2], o[3]);
            *(u32x2*)(H + (size_t)row * DM + col) = w;
        }
    }
}
DI void pool_phase(const bf16_t* H, bf16_t* P, int G, int bid, int wid0) {
    const int gtid = bid * 512 + opaque_tid(wid0), NT = G * 512;
    for (int it = gtid; it < MTOT * 128; it += NT) {
        const int row = it >> 7, c8 = (it & 127) * 8;
        const int grp = c8 >> 8, hw = 1 << grp;
        int t, T, rbase;
        if (row < MLAT) { t = row & (SEQ - 1); T = SEQ; rbase = row - t; } else { t = (row - MLAT) & (CTXL - 1); T = CTXL; rbase = row - t; }
        const int lo = t - hw < 0 ? 0 : t - hw, hi = t + hw > T ? T : t + hw;
        float a[8];
#pragma unroll
        for (int e = 0; e < 8; ++e) a[e] = 0.f;
        for (int tt = lo; tt < hi; ++tt) {
            const u32x4 w = *(const u32x4*)(H + (size_t)(rbase + tt) * DM + c8);
            a[0] += bflo(w.x); a[1] += bfhi(w.x); a[2] += bflo(w.y); a[3] += bfhi(w.y); a[4] += bflo(w.z); a[5] += bfhi(w.z); a[6] += bflo(w.w); a[7] += bfhi(w.w);
        }
        const float inv = 1.0f / (float)(hi - lo);
        const u32x4 w = *(const u32x4*)(H + (size_t)row * DM + c8);
        u32x4 o;
        o.x = pk2(a[0] * inv - bflo(w.x), a[1] * inv - bfhi(w.x)); o.y = pk2(a[2] * inv - bflo(w.y), a[3] * inv - bfhi(w.y));
        o.z = pk2(a[4] * inv - bflo(w.z), a[5] * inv - bfhi(w.z)); o.w = pk2(a[6] * inv - bflo(w.w), a[7] * inv - bfhi(w.w));
        *(u32x4*)(P + (size_t)row * DM + c8) = o;
    }
}

constexpr int AT_KOFF = 0, AT_VOFF = 128 * 144, AT_PITCH = 144;
DI void attn_phase(LAS unsigned char* lds, const bf16_t* QKV, bf16_t* AO, const float* sink, bool do_ctx, int G, int bid, int wid0) {
    const int tid = opaque_tid(wid0), lane = tid & 63, wid = __builtin_amdgcn_readfirstlane(tid >> 6);
    const int r = lane & 31, hh = lane >> 5, i16 = lane & 15, q4 = i16 >> 2, p4 = i16 & 3, blk = (lane >> 4) & 1;
    const int nunits = 2048 + (do_ctx ? 64 : 0);
    for (int u = bid; u < nunits; u += G) {
        int b, kvh, qb; bool isctx;
        if (u < 2048) { b = u >> 8; kvh = (u >> 6) & 3; qb = u & 63; isctx = false; } else { const int v = u - 2048; b = v >> 3; kvh = (v >> 1) & 3; qb = v & 1; isctx = true; }
        const size_t qrow0 = isctx ? (size_t)(MLAT + b * CTXL + qb * 128) : (size_t)(b * SEQ + qb * 128);
        const int g = wid >> 1, qh = wid & 1, head = kvh * 4 + g;
        bf16x8 qf[2][4];
#pragma unroll
        for (int qt = 0; qt < 2; ++qt)
#pragma unroll
            for (int s = 0; s < 4; ++s) qf[qt][s] = *(const bf16x8*)(QKV + (qrow0 + qh * 64 + qt * 32 + r) * 1536 + head * 64 + 16 * s + 8 * hh);
        f32x16 o[2][2]; float l[2] = {0.f, 0.f};
#pragma unroll
        for (int a = 0; a < 2; ++a)
#pragma unroll
            for (int c = 0; c < 2; ++c)
#pragma unroll
                for (int e = 0; e < 16; ++e) o[a][c][e] = 0.f;
        for (int c = 0; c < 5; ++c) {
            size_t krow0; bool local;
            if (c < 3) { if (isctx) continue; const int kb = qb - 1 + c; if (kb < 0 || kb > 63) continue; krow0 = (size_t)(b * SEQ + kb * 128); local = true; }
            else { krow0 = (size_t)(MLAT + b * CTXL + (c - 3) * 128); local = false; }
            __syncthreads();
#pragma unroll
            for (int i = 0; i < 2; ++i) {
                const int p = tid + 512 * i, row = p >> 3, ch = p & 7;
                const u32x4 kv = *(const u32x4*)(QKV + (krow0 + row) * 1536 + 1024 + kvh * 64 + ch * 8);
                const u32x4 vv = *(const u32x4*)(QKV + (krow0 + row) * 1536 + 1280 + kvh * 64 + ch * 8);
                *(LAS u32x4*)(lds + AT_KOFF + row * AT_PITCH + ch * 16) = kv;
                *(LAS u32x4*)(lds + AT_VOFF + row * AT_PITCH + ch * 16) = vv;
            }
            __syncthreads();
            const int relbase = (c - 1) * 128;
#pragma unroll 1
            for (int kb32 = 0; kb32 < 4; ++kb32) {
                bf16x8 kf[4];
#pragma unroll
                for (int s = 0; s < 4; ++s) kf[s] = *(const LAS bf16x8*)(lds + AT_KOFF + (kb32 * 32 + r) * AT_PITCH + (16 * s + 8 * hh) * 2);
                bf16x8 vf[2][2];
#pragma unroll
                for (int dt = 0; dt < 2; ++dt)
#pragma unroll
                    for (int s2 = 0; s2 < 2; ++s2) {
                        const LAS unsigned char* vp = lds + AT_VOFF + (kb32 * 32 + 16 * s2 + 4 * hh + q4) * AT_PITCH + (dt * 32 + 16 * blk) * 2 + 8 * p4;
                        vf[dt][s2] = cat8(trd(vp), trd(vp + 8 * AT_PITCH));
                    }
#pragma unroll
                for (int qt = 0; qt < 2; ++qt) {
                    f32x16 sa;
#pragma unroll
                    for (int e = 0; e < 16; ++e) sa[e] = 0.f;
#pragma unroll
                    for (int s = 0; s < 4; ++s) sa = MFMA32(kf[s], qf[qt][s], sa);
                    const int qi = qh * 64 + qt * 32 + r;
                    float ls = 0.f;
#pragma unroll
                    for (int e = 0; e < 16; ++e) {
                        float p = __expf(sa[e]);
                        if (local) { const int rel = relbase + kb32 * 32 + crow(e, hh) - qi; if (rel > 128 || rel < -128) p = 0.f; }
                        sa[e] = p; ls += p;
                    }
                    l[qt] += ls;
                    const bf16x8 p0 = pack8(sa, 0), p1 = pack8(sa, 1);
#pragma unroll
                    for (int dt = 0; dt < 2; ++dt) { o[dt][qt] = MFMA32(vf[dt][0], p0, o[dt][qt]); o[dt][qt] = MFMA32(vf[dt][1], p1, o[dt][qt]); }
                }
            }
        }
        const float es = __expf(sink[head]);
#pragma unroll
        for (int qt = 0; qt < 2; ++qt) {
            const float lt = l[qt] + shx(l[qt], 32, lane) + es;
            const float inv = 1.0f / lt;
            bf16_t* op = AO + (qrow0 + qh * 64 + qt * 32 + r) * DM + head * 64;
#pragma unroll
            for (int dt = 0; dt < 2; ++dt)
#pragma unroll
                for (int g4 = 0; g4 < 4; ++g4) {
                    u32x2 w; w.x = pk2(o[dt][qt][4 * g4] * inv, o[dt][qt][4 * g4 + 1] * inv); w.y = pk2(o[dt][qt][4 * g4 + 2] * inv, o[dt][qt][4 * g4 + 3] * inv);
                    *(u32x2*)(op + dt * 32 + 8 * g4 + 4 * hh) = w;
                }
        }
    }
}

DI float ret_log2g(int h, int dir) { return log2f(1.0f - exp2f(-5.0f - (dir ? 0.5f : 0.0f) - (float)h)); }
constexpr int RI_PITCH = 1040;
DI void ret_intra_phase(LAS unsigned char* lds, const bf16_t* RQKV, bf16_t* YF, bf16_t* YB, int G, int bid, int wid0) {
    const int tid = opaque_tid(wid0), lane = tid & 63, wid = __builtin_amdgcn_readfirstlane(tid >> 6);
    const int r = lane & 31, hh = lane >> 5, i16 = lane & 15, q4 = i16 >> 2, p4 = i16 & 3, blk = (lane >> 4) & 1;
    const int it = wid & 3, dir = wid >> 2;
    for (int u = bid; u < 1056; u += G) {
        const int b4 = u / 264, rem = u % 264, h = rem / 66, ch = rem % 66;
        const size_t lrow0 = ch < 64 ? (size_t)(b4 * SEQ + ch * 128) : (size_t)(4 * SEQ + b4 * CTXL + (ch - 64) * 128);
        __syncthreads();
#pragma unroll 4
        for (int i = 0; i < 16; ++i) {
            const int p = tid + 512 * i, row = p >> 6, cn = p & 63;
            *(LAS u32x4*)(lds + row * RI_PITCH + cn * 16) = *(const u32x4*)(RQKV + (lrow0 + row) * 4096 + 2048 + h * 512 + cn * 8);
        }
        const bf16_t* qp = RQKV + (lrow0 + it * 32 + r) * 4096 + h * 256 + 8 * hh;
        const float l2g = ret_log2g(h, dir);
        bf16x8 pf[4][2];
#pragma unroll
        for (int jt = 0; jt < 4; ++jt) {
            const bool need = dir == 0 ? (jt <= it) : (jt >= it);
            if (need) {
                f32x16 sa;
#pragma unroll
                for (int e = 0; e < 16; ++e) sa[e] = 0.f;
                const bf16_t* kp = RQKV + (lrow0 + jt * 32 + r) * 4096 + 1024 + h * 256 + 8 * hh;
#pragma unroll 8
                for (int s = 0; s < 16; ++s) {
                    const bf16x8 kf = *(const bf16x8*)(kp + 16 * s);
                    sa = MFMA32(kf, *(const bf16x8*)(qp + 16 * s), sa);
                }
                const int i = it * 32 + r;
#pragma unroll
                for (int e = 0; e < 16; ++e) {
                    const int j = jt * 32 + crow(e, hh); const int diff = dir == 0 ? i - j : j - i;
                    sa[e] = diff >= 0 ? sa[e] * exp2f((float)diff * l2g) : 0.f;
                }
                pf[jt][0] = pack8(sa, 0); pf[jt][1] = pack8(sa, 1);
            } else { pf[jt][0] = (bf16x8){0, 0, 0, 0, 0, 0, 0, 0}; pf[jt][1] = pf[jt][0]; }
        }
        __syncthreads();
        bf16_t* Y = (dir ? YB : YF) + (lrow0 + it * 32 + r) * 2048 + h * 512;
#pragma unroll 1
        for (int vt = 0; vt < 16; ++vt) {
            f32x16 acc;
#pragma unroll
            for (int e = 0; e < 16; ++e) acc[e] = 0.f;
#pragma unroll
            for (int jt = 0; jt < 4; ++jt) {
                const bool need = dir == 0 ? (jt <= it) : (jt >= it);
                if (need) {
#pragma unroll
                    for (int s2 = 0; s2 < 2; ++s2) {
                        const LAS unsigned char* vp = lds + (jt * 32 + 16 * s2 + 4 * hh + q4) * RI_PITCH + (vt * 32 + 16 * blk) * 2 + 8 * p4;
                        acc = MFMA32(cat8(trd(vp), trd(vp + 8 * RI_PITCH)), pf[jt][s2], acc);
                    }
                }
            }
#pragma unroll
            for (int g4 = 0; g4 < 4; ++g4) {
                u32x2 w; w.x = pk2(acc[4 * g4], acc[4 * g4 + 1]); w.y = pk2(acc[4 * g4 + 2], acc[4 * g4 + 3]);
                *(u32x2*)(Y + vt * 32 + 8 * g4 + 4 * hh) = w;
            }
        }
    }
}

constexpr int RS_KS = 0, RS_KP = 528, RS_VS = 128 * 528, RS_VP = 144, RS_ST = RS_VS + 128 * 144, RS_SP = 528;
DI void ret_scan_phase(LAS unsigned char* lds, const bf16_t* RQKV, bf16_t* YF, bf16_t* YB, float* SS, int G, int bid, int wid0) {
    const int tid = opaque_tid(wid0), lane = tid & 63, wid = __builtin_amdgcn_readfirstlane(tid >> 6);
    const int r = lane & 31, hh = lane >> 5, i16 = lane & 15, q4 = i16 >> 2, p4 = i16 & 3, blk = (lane >> 4) & 1;
    const int vta = wid >> 2, ita = wid & 3;
    for (int item = bid; item < 256; item += G) {
        const int sl = item & 7, dir = (item >> 3) & 1, h = (item >> 4) & 3, b4 = item >> 6;
        bf16_t* Y = dir ? YB : YF;
        const float l2g = ret_log2g(h, dir);
        f32x16 S[2];
#pragma unroll
        for (int e = 0; e < 16; ++e) { S[0][e] = 0.f; S[1][e] = 0.f; }
        __syncthreads();
        for (int i = tid; i < 64 * RS_SP / 4; i += 512) *(LAS unsigned*)(lds + RS_ST + 4 * i) = 0u;
        const float cdec = exp2f(l2g * 128.0f);
        for (int step = 0; step < 66; ++step) {
            int ch;
            if (dir == 0) ch = step < 2 ? 64 + step : step - 2; else ch = step < 2 ? 65 - step : 65 - step;
            const size_t lrow0 = ch < 64 ? (size_t)(b4 * SEQ + ch * 128) : (size_t)(4 * SEQ + b4 * CTXL + (ch - 64) * 128);
#pragma unroll
            for (int i = 0; i < 8; ++i) {
                const int p = tid + 512 * i, row = p >> 5, c16 = p & 31;
                *(LAS u32x4*)(lds + RS_KS + row * RS_KP + c16 * 16) = *(const u32x4*)(RQKV + (lrow0 + row) * 4096 + 1024 + h * 256 + c16 * 8);
            }
#pragma unroll
            for (int i = 0; i < 2; ++i) {
                const int p = tid + 512 * i, row = p >> 3, c16 = p & 7;
                const u32x4 w = *(const u32x4*)(RQKV + (lrow0 + row) * 4096 + 2048 + h * 512 + sl * 64 + c16 * 8);
                const float kd = exp2f(l2g * (float)(dir ? row : 127 - row));
                u32x4 o; o.x = pk2(bflo(w.x) * kd, bfhi(w.x) * kd); o.y = pk2(bflo(w.y) * kd, bfhi(w.y) * kd); o.z = pk2(bflo(w.z) * kd, bfhi(w.z) * kd); o.w = pk2(bflo(w.w) * kd, bfhi(w.w) * kd);
                *(LAS u32x4*)(lds + RS_VS + row * RS_VP + c16 * 16) = o;
            }
            __syncthreads();
            {
                f32x16 acc;
#pragma unroll
                for (int e = 0; e < 16; ++e) acc[e] = 0.f;
                const bf16_t* qp = RQKV + (lrow0 + ita * 32 + r) * 4096 + h * 256 + 8 * hh;
                const LAS unsigned char* sp = lds + RS_ST + (vta * 32 + r) * RS_SP + 16 * hh;
#pragma unroll
                for (int s = 0; s < 16; ++s) acc = MFMA32(*(const LAS bf16x8*)(sp + 32 * s), *(const bf16x8*)(qp + 16 * s), acc);
                const int i = ita * 32 + r;
                const float qd = exp2f(l2g * (float)(dir ? 128 - i : i + 1));
                bf16_t* yp = Y + (lrow0 + i) * 2048 + h * 512 + sl * 64 + vta * 32 + 4 * hh;
                float ssq = 0.f;
#pragma unroll
                for (int g4 = 0; g4 < 4; ++g4) {
                    const u32x2 yi = *(const u32x2*)(yp + 8 * g4);
                    const float y0 = acc[4 * g4] * qd + bflo(yi.x), y1 = acc[4 * g4 + 1] * qd + bfhi(yi.x), y2 = acc[4 * g4 + 2] * qd + bflo(yi.y), y3 = acc[4 * g4 + 3] * qd + bfhi(yi.y);
                    ssq += (y0 * y0 + y1 * y1) + (y2 * y2 + y3 * y3);
                    u32x2 w; w.x = pk2(y0, y1); w.y = pk2(y2, y3);
                    *(u32x2*)(yp + 8 * g4) = w;
                }
                ssq += shx(ssq, 32, lane);
                if (hh == 0) SS[(((lrow0 + i) * 4 + h) * 2 + dir) * 16 + sl * 2 + vta] = ssq;
            }
            {
#pragma unroll
                for (int e = 0; e < 16; ++e) { S[0][e] *= cdec; S[1][e] *= cdec; }
#pragma unroll
                for (int s = 0; s < 8; ++s) {
                    const LAS unsigned char* kp = lds + RS_KS + (16 * s + 8 * hh + q4) * RS_KP + (wid * 32 + 16 * blk) * 2 + 8 * p4;
                    const bf16x8 ka = cat8(trd(kp), trd(kp + 4 * RS_KP));
#pragma unroll
                    for (int vt = 0; vt < 2; ++vt) {
                        const LAS unsigned char* vp = lds + RS_VS + (16 * s + 8 * hh + q4) * RS_VP + (vt * 32 + 16 * blk) * 2 + 8 * p4;
                        S[vt] = MFMA32(ka, cat8(trd(vp), trd(vp + 4 * RS_VP)), S[vt]);
                    }
                }
            }
            __syncthreads();
#pragma unroll
            for (int vt = 0; vt < 2; ++vt)
#pragma unroll
                for (int g4 = 0; g4 < 4; ++g4) {
                    u32x2 w; w.x = pk2(S[vt][4 * g4], S[vt][4 * g4 + 1]); w.y = pk2(S[vt][4 * g4 + 2], S[vt][4 * g4 + 3]);
                    *(LAS u32x2*)(lds + RS_ST + (vt * 32 + r) * RS_SP + (wid * 32 + 8 * g4 + 4 * hh) * 2) = w;
                }
        }
    }
}

__global__ void __launch_bounds__(512) fwd_megakernel(Params P) {
    extern __shared__ __attribute__((aligned(16))) unsigned char lds_raw[];
    LAS unsigned char* lds = (LAS unsigned char*)lds_raw;
    cg::grid_group grid = cg::this_grid();
    const int G = gridDim.x, bid = blockIdx.x;
    const int wid0 = __builtin_amdgcn_readfirstlane(threadIdx.x >> 6);
    unsigned char* ws = P.ws;
#define MOD ((float*)(ws + WS_MOD))
#define ROPEA_C ((float*)(ws + WS_ROPEA))
#define ROPEA_S (ROPEA_C + SEQ * 32)
#define ROPER_C ((float*)(ws + WS_ROPER))
#define ROPER_S (ROPER_C + SEQ * 128)
#define XC ((float*)(ws + WS_XC))
#define SS ((float*)(ws + WS_SS))
#define WQKV ((bf16_t*)(ws + WS_WQKV))
#define WAO ((bf16_t*)(ws + WS_WAO))
#define WP ((bf16_t*)(ws + WS_WP))
#define WIN ((bf16_t*)(ws + WS_WIN))
#define WRO ((bf16_t*)(ws + WS_WRO))
#define WGU ((bf16_t*)(ws + WS_WGU))
#define WD ((bf16_t*)(ws + WS_WD))
#define H ((bf16_t*)(ws + WS_H))
#define QKV ((bf16_t*)(ws + WS_QKV))
#define AO ((bf16_t*)(ws + WS_AO))
#define HID ((bf16_t*)(ws + WS_HID))
#define POOLED ((bf16_t*)(ws + WS_POOLED))
#define RQKV ((bf16_t*)(ws + WS_RQKV))
#define YF ((bf16_t*)(ws + WS_YF))
#define YB ((bf16_t*)(ws + WS_YB))
#define Z ((bf16_t*)(ws + WS_Z))
#ifndef SKIP_PRO
    {
        const int tid = opaque_tid(wid0), lane = tid & 63, wid = __builtin_amdgcn_readfirstlane(tid >> 6);
        const int gw = bid * 8 + wid, NGW = G * 8, gtid = bid * 512 + tid, NT = G * 512;
        LAS float* sc = (LAS float*)lds;
        for (int blk = bid; blk < 48; blk += G) {
            __syncthreads();
            for (int i = tid; i < 9 * DM; i += 512) { const int bb = i >> 10, k = i & 1023; const float v = bb < 8 ? P.c[bb * DM + k] : P.c_ctx[k]; sc[i] = silu_f(v); }
            __syncthreads();
            const int idx = blk * 512 + tid, l = idx / MODW, n = idx % MODW;
            const float* w = P.ada_w + (size_t)l * DM * MODW + n;
            float a[9];
#pragma unroll
            for (int bb = 0; bb < 9; ++bb) a[bb] = 0.f;
#pragma unroll 4
            for (int k = 0; k < DM; ++k) {
                const float wv = w[(size_t)k * MODW];
#pragma unroll
                for (int bb = 0; bb < 9; ++bb) a[bb] += sc[bb * DM + k] * wv;
            }
            const float bv = P.ada_b[l * MODW + n];
#pragma unroll
            for (int bb = 0; bb < 9; ++bb) MOD[(l * 9 + bb) * MODW + n] = a[bb] + bv;
        }
        __syncthreads();
        for (int i = gtid; i < SEQ * 32; i += NT) {
            const int t = i >> 5, j = i & 31; const float pos = (float)(j < 16 ? (t >> 6) : (t & 63));
            const float inv = powf(10000.0f, -(float)(j & 15) / 16.0f); const float ang = pos * inv;
            ROPEA_C[i] = cosf(ang); ROPEA_S[i] = sinf(ang);
        }
        for (int i = gtid; i < SEQ * 128; i += NT) {
            const int t = i >> 7, j = i & 127;
            const float inv = powf(10000.0f, -((float)j / 127.0f)); const float ang = (float)t * inv;
            ROPER_C[i] = cosf(ang); ROPER_S[i] = sinf(ang);
        }
        LAS float* scr = (LAS float*)(lds + 40960 + wid * 8704);
        int cnt = 0;
        for (int s = 0; s < 2; ++s) {
            transpose_matrix(P.attn_w_qkv + (size_t)s * DM * 1536, DM, 1536, 0, 1536, WQKV + (size_t)s * 1536 * DM, DM, 0, 1, scr, lane, gw, NGW, cnt);
            transpose_matrix(P.attn_w_o + (size_t)s * DM * DM, DM, DM, 0, DM, WAO + (size_t)s * DM * DM, DM, 0, 0, scr, lane, gw, NGW, cnt);
        }
        for (int g = 0; g < 4; ++g) transpose_matrix(P.pool_w + (size_t)g * 256 * 256, 256, 256, 0, 256, WP, 256, g * 256, 0, scr, lane, gw, NGW, cnt);
        transpose_matrix(P.ret_w_in, DM, 8192, 0, 4096, WIN, DM, 0, 0, scr, lane, gw, NGW, cnt);
        transpose_matrix(P.ret_w_in, DM, 8192, 4096, 2048, WIN, DM, 4096, 2, scr, lane, gw, NGW, cnt);
        transpose_matrix(P.ret_w_in, DM, 8192, 6144, 2048, WIN, DM, 4096, 3, scr, lane, gw, NGW, cnt);
        transpose_matrix(P.ret_w_o, 2048, DM, 0, DM, WRO, 2048, 0, 0, scr, lane, gw, NGW, cnt);
        for (int l = 0; l < 4; ++l) {
            transpose_matrix(P.ffn_w_gate + (size_t)l * DM * FFH, DM, FFH, 0, FFH, WGU + (size_t)l * 5632 * DM, DM, 0, 2, scr, lane, gw, NGW, cnt);
            transpose_matrix(P.ffn_w_up + (size_t)l * DM * FFH, DM, FFH, 0, FFH, WGU + (size_t)l * 5632 * DM, DM, 0, 3, scr, lane, gw, NGW, cnt);
            transpose_matrix(P.ffn_w_down + (size_t)l * FFH * DM, FFH, DM, 0, DM, WD + (size_t)l * DM * FFH, FFH, 0, 0, scr, lane, gw, NGW, cnt);
        }
    }
#endif
    grid.sync();

    const float* bl = P.x; const float* bc = P.ctx;
#pragma unroll 1
    for (int layer = 0; layer < 4; ++layer) {
        const int kind = layer % 3, slot = layer / 3;
        const float* modl = MOD + (size_t)layer * 9 * MODW;
#ifndef SKIP_EW
        prenorm_phase(bl, bc, P.norm_mix + layer * DM, modl, 0, 1, H, G, bid, wid0);
#endif
        grid.sync();
        if (kind == 0) {
            {
                pg8::Gemm g{H, WQKV + (size_t)slot * 1536 * DM, DM, DM, DM, 0, 0}; pg8::Sched S; S.init(NTILE_M, 6, G, bid, NTILE_M, 0, 0);
                pg8::EpiAttnQKV E{QKV, P.attn_q_norm + slot * 64, P.attn_k_norm + slot * 64, ROPEA_C, ROPEA_S};

#ifndef SKIP_G_QKV
                pg8::gemm_phase(lds, g, S, E, wid0);
#endif

            }
            grid.sync();

#ifndef SKIP_ATTN
            attn_phase(lds, QKV, AO, P.attn_sink + slot * 16, layer < 3, G, bid, wid0);
#endif

            grid.sync();
            {
                pg8::Gemm g{AO, WAO + (size_t)slot * DM * DM, DM, DM, DM, 0, 0}; pg8::Sched S; S.init(NTILE_M, 4, G, bid, NTILE_M, 0, 0);
                pg8::EpiResid E{bl, bc, P.out, XC, modl + 2 * DM, nullptr};

#ifndef SKIP_G_AO
                pg8::gemm_phase(lds, g, S, E, wid0);
#endif

            }
        } else if (kind == 1) {
#ifndef SKIP_EW
            pool_phase(H, POOLED, G, bid, wid0);
#endif
            grid.sync();
            {
                pg8::Gemm g{POOLED, WP, DM, 256, 256, 0, 1}; pg8::Sched S; S.init(NTILE_M, 4, G, bid, NTILE_M, 0, 0);
                pg8::EpiResid E{bl, bc, P.out, XC, modl + 2 * DM, P.pool_scale + slot * DM};

#ifndef SKIP_G_POOL
                pg8::gemm_phase(lds, g, S, E, wid0);
#endif

            }
        } else {
            for (int hb = 0; hb < 2; ++hb) {
                const int s0b = hb * 128, s1b = 256 + hb * 4;
                {
                    pg8::Gemm g{H, WIN, DM, DM, DM, 0, 0}; pg8::Sched S; S.init(132, 16, G, bid, 128, s0b, s1b);
                    pg8::EpiRetQKV E{RQKV, ROPER_C, ROPER_S};

#ifndef SKIP_G_RQKV
                pg8::gemm_phase(lds, g, S, E, wid0);
#endif

                }
                grid.sync();

#ifndef SKIP_RI
                ret_intra_phase(lds, RQKV, YF, YB, G, bid, wid0);
#endif

                grid.sync();

#ifndef SKIP_RS
                ret_scan_phase(lds, RQKV, YF, YB, SS, G, bid, wid0);
#endif

                grid.sync();
                {
                    pg8::Gemm g{H, WIN + (size_t)4096 * DM, DM, DM, DM, 0, 0}; pg8::Sched S; S.init(132, 16, G, bid, 128, s0b, s1b);
                    pg8::EpiRetGate E{YF, YB, SS, Z};

#ifndef SKIP_G_RGATE
                pg8::gemm_phase(lds, g, S, E, wid0);
#endif

                }
                grid.sync();
                {
                    pg8::Gemm g{Z, WRO, 2048, 2048, 2048, 1, 0}; pg8::Sched S; S.init(132, 4, G, bid, 128, s0b, s1b);
                    pg8::EpiResid E{bl, bc, P.out, XC, modl + 2 * DM, nullptr};

#ifndef SKIP_G_RWO
                pg8::gemm_phase(lds, g, S, E, wid0);
#endif

                }
                if (hb == 0) grid.sync();
            }
        }
        grid.sync();
        bl = P.out; bc = XC;
#ifndef SKIP_EW
        prenorm_phase(bl, bc, P.norm_ffn + layer * DM, modl, 3, 4, H, G, bid, wid0);
#endif
        grid.sync();
        {
            pg8::Gemm g{H, WGU + (size_t)layer * 5632 * DM, DM, DM, DM, 0, 0}; pg8::Sched S; S.init(NTILE_M, 22, G, bid, NTILE_M, 0, 0);
            pg8::EpiSwiGLU E{HID};

#ifndef SKIP_G_GU
                pg8::gemm_phase(lds, g, S, E, wid0);
#endif

        }
        grid.sync();
        {
            pg8::Gemm g{HID, WD + (size_t)layer * DM * FFH, FFH, FFH, FFH, 0, 0}; pg8::Sched S; S.init(NTILE_M, 4, G, bid, NTILE_M, 0, 0);
            pg8::EpiResid E{bl, bc, P.out, XC, modl + 5 * DM, nullptr};

#ifndef SKIP_G_DOWN
                pg8::gemm_phase(lds, g, S, E, wid0);
#endif

        }
        grid.sync();
    }
}

extern "C" void kernel_launch(void* const* d_in, const int* in_sizes, int n_in, void* d_out, int out_size, void* d_ws, size_t ws_size, hipStream_t stream) {
    static int grid_blocks = 0;
    if (grid_blocks == 0) {
        if (n_in != 20 || ws_size < WS_END) { fprintf(stderr, "kernel_launch: unexpected inputs (n_in %d, ws %zu)\n", n_in, ws_size); grid_blocks = -1; return; }
        int dev = 0, cus = 0, per_cu = 0;
        hipGetDevice(&dev);
        hipDeviceGetAttribute(&cus, hipDeviceAttributeMultiprocessorCount, dev);
        if (hipFuncSetAttribute((const void*)fwd_megakernel, hipFuncAttributeMaxDynamicSharedMemorySize, LDS_BYTES) != hipSuccess) { fprintf(stderr, "kernel_launch: hipFuncSetAttribute failed\n"); grid_blocks = -1; return; }
        if (hipOccupancyMaxActiveBlocksPerMultiprocessor(&per_cu, (const void*)fwd_megakernel, 512, LDS_BYTES) != hipSuccess || per_cu < 1) { fprintf(stderr, "kernel_launch: occupancy query failed (%d)\n", per_cu); per_cu = 1; (void)hipGetLastError(); }
        grid_blocks = cus * per_cu;
    }
    if (grid_blocks < 0) return;
    Params p{};
    p.x = (const float*)d_in[0]; p.c = (const float*)d_in[1]; p.ctx = (const float*)d_in[2]; p.c_ctx = (const float*)d_in[3]; p.ada_w = (const float*)d_in[4]; p.ada_b = (const float*)d_in[5];
    p.norm_mix = (const float*)d_in[6]; p.norm_ffn = (const float*)d_in[7]; p.attn_w_qkv = (const float*)d_in[8]; p.attn_w_o = (const float*)d_in[9]; p.attn_q_norm = (const float*)d_in[10];
    p.attn_k_norm = (const float*)d_in[11]; p.attn_sink = (const float*)d_in[12]; p.pool_w = (const float*)d_in[13]; p.pool_scale = (const float*)d_in[14]; p.ret_w_in = (const float*)d_in[15];
    p.ret_w_o = (const float*)d_in[16]; p.ffn_w_gate = (const float*)d_in[17]; p.ffn_w_up = (const float*)d_in[18]; p.ffn_w_down = (const float*)d_in[19];
    p.out = (float*)d_out; p.ws = (unsigned char*)d_ws;
    void* args[] = {&p};
    hipError_t e = hipLaunchCooperativeKernel((const void*)fwd_megakernel, dim3(grid_blocks), dim3(512), args, LDS_BYTES, stream);
    if (e != hipSuccess) fprintf(stderr, "cooperative launch failed: %s (grid %d)\n", hipGetErrorString(e), grid_blocks);
}
```

```cpp
#include <hip/hip_runtime.h>
#include <hip/hip_cooperative_groups.h>
#include <cstdio>
#include <cstdint>
namespace cg = cooperative_groups;

#define DI __device__ __forceinline__
#define LAS __attribute__((address_space(3)))
typedef unsigned short bf16_t;
typedef short bf16x8 __attribute__((ext_vector_type(8)));
typedef short s16x4 __attribute__((ext_vector_type(4)));
typedef float f32x4 __attribute__((ext_vector_type(4)));
typedef float f32x16 __attribute__((ext_vector_type(16)));
typedef unsigned u32x4 __attribute__((ext_vector_type(4)));
typedef unsigned u32x2 __attribute__((ext_vector_type(2)));
typedef float f32x2_t __attribute__((ext_vector_type(2)));
typedef __bf16 bf16x2_t __attribute__((ext_vector_type(2)));
typedef short v4i16_t __attribute__((ext_vector_type(4)));

DI unsigned pk2(float lo, float hi) { f32x2_t v = {lo, hi}; bf16x2_t b = __builtin_convertvector(v, bf16x2_t); return __builtin_bit_cast(unsigned, b); }
DI float bflo(unsigned w) { return __uint_as_float(w << 16); }
DI float bfhi(unsigned w) { return __uint_as_float(w & 0xffff0000u); }
DI float silu_f(float x) { return x * __builtin_amdgcn_rcpf(1.0f + __expf(-x)); }
DI int crow(int reg, int h) { return (reg & 3) + 8 * (reg >> 2) + 4 * h; }
DI float shx(float v, int m, int lane) { return __int_as_float(__builtin_amdgcn_ds_bpermute((lane ^ m) << 2, __float_as_int(v))); }
DI float wave_sum(float v, int lane) {
#pragma unroll
    for (int o = 1; o < 64; o <<= 1) v += shx(v, o, lane);
    return v;
}
DI int opaque_tid(int wid0) { int l; asm volatile("v_mbcnt_lo_u32_b32 %0, -1, 0\n\tv_mbcnt_hi_u32_b32 %0, -1, %0" : "=v"(l)); return wid0 * 64 + l; }
DI int opq(int v) { asm volatile("" : "+v"(v)); return v; }
#define LDS_BARRIER() do { asm volatile("s_waitcnt lgkmcnt(0)" ::: "memory"); __builtin_amdgcn_s_barrier(); asm volatile("" ::: "memory"); } while (0)
#define MFMA32(a, b, c) __builtin_amdgcn_mfma_f32_32x32x16_bf16((a), (b), (c), 0, 0, 0)
DI s16x4 trd(const LAS unsigned char* p) { return __builtin_bit_cast(s16x4, __builtin_amdgcn_ds_read_tr16_b64_v4i16((LAS v4i16_t*)p)); }
DI bf16x8 cat8(s16x4 lo, s16x4 hi) { return __builtin_shufflevector(lo, hi, 0, 1, 2, 3, 4, 5, 6, 7); }
DI bf16x8 pack8(const f32x16& x, int s) {
    u32x4 p; p.x = pk2(x[8 * s], x[8 * s + 1]); p.y = pk2(x[8 * s + 2], x[8 * s + 3]); p.z = pk2(x[8 * s + 4], x[8 * s + 5]); p.w = pk2(x[8 * s + 6], x[8 * s + 7]);
    return __builtin_bit_cast(bf16x8, p);
}

constexpr int DM = 1024, NB = 8, SEQ = 8192, CTXL = 256, FFH = 2816;
constexpr int MLAT = NB * SEQ, MCTX = NB * CTXL, MTOT = MLAT + MCTX;
constexpr int NTILE_M = MTOT / 256;
constexpr int MODW = 6 * DM;
constexpr int MHALF = 4 * SEQ + 4 * CTXL;
constexpr float NEPS = 1e-6f;

constexpr size_t MiB = 1u << 20;
constexpr size_t WS_MOD = 0;
constexpr size_t WS_CTL = 896 * 1024;
constexpr size_t WS_ROPEA = 1 * MiB;
constexpr size_t WS_ROPER = 3 * MiB;
constexpr size_t WS_XC = 11 * MiB;
constexpr size_t WS_SS = 19 * MiB;
constexpr size_t WS_WQKV = 36 * MiB;
constexpr size_t WS_WAO = 42 * MiB;
constexpr size_t WS_WP = 46 * MiB;
constexpr size_t WS_WIN = 47 * MiB;
constexpr size_t WS_WRO = 63 * MiB;
constexpr size_t WS_WGU = 67 * MiB;
constexpr size_t WS_WD = 111 * MiB;
constexpr size_t WS_H = 133 * MiB;
constexpr size_t WS_BIG = 265 * MiB;
constexpr size_t WS_QKV = WS_BIG;
constexpr size_t WS_AO = WS_BIG + 198 * MiB;
constexpr size_t WS_HID = WS_BIG;
constexpr size_t WS_POOLED = WS_BIG;
constexpr size_t WS_RQKV = WS_BIG;
constexpr size_t WS_YF = WS_BIG + 264 * MiB;
constexpr size_t WS_YB = WS_BIG + 396 * MiB;
constexpr size_t WS_Z = WS_BIG + 528 * MiB;
constexpr size_t WS_END = WS_BIG + 660 * MiB;

constexpr int LDS_BYTES = 147456;

namespace pg8 {
constexpr int BM = 256, BK = 64, HALF = 128, HTB = HALF * BK * 2, STAGE_BYTES = 8 * HTB, NXCD = 8, WGM = 8;
DI int lds_byte(int r, int c) { const int st = (r >> 4) * 2 + (c >> 5), rr = r & 15, cc = c & 31, ob = rr * 64 + cc * 2; return st * 1024 + (ob ^ (((ob >> 9) & 1) << 5)); }
DI void stage_rc(int b, int& R, int& C) { const int st = b / 1024, sb = b % 1024, swz = sb ^ (((sb >> 9) & 1) << 5); R = (st >> 1) * 16 + swz / 64; C = (st & 1) * 32 + (swz % 64) / 2; }
DI int perm32(int rho) { const int n = rho >> 4, i = rho & 15; return 8 * (i >> 2) + 4 * n + (i & 3); }

struct Unit { int pm, pn, lt; };
struct Gemm { const bf16_t* A; const bf16_t* Bt; int lda, ldb, K; int a_local; int grouped; };

struct Sched {
    int nM, nN, nwg, G, c, s0n, s0b, s1b;
    DI void init(int nM_, int nN_, int G_, int c_, int s0n_, int s0b_, int s1b_) { nM = nM_; nN = nN_; nwg = nM * nN; G = G_; c = c_; s0n = s0n_; s0b = s0b_; s1b = s1b_; }
    DI bool next(int i, Unit& u) const {
        const long L = (long)i * G + c; if (L >= nwg) return false;
        int wgid = (int)L; { const int q = nwg / NXCD, r = nwg % NXCD, xcd = wgid % NXCD, off = wgid / NXCD; wgid = (xcd < r ? xcd * (q + 1) : r * (q + 1) + (xcd - r) * q) + off; }
        const int nig = WGM * nN, gid = wgid / nig, fm = gid * WGM, gsz = (nM - fm) < WGM ? (nM - fm) : WGM;
        const int t = fm + ((wgid % nig) % gsz); u.pn = (wgid % nig) / gsz; u.lt = t; u.pm = t < s0n ? s0b + t : s1b + (t - s0n); return true;
    }
};

template <class Epi>
DI void gemm_phase(LAS unsigned char* lds, const Gemm g, const Sched& S, const Epi& E, int wid0) {
    const int tid = opaque_tid(wid0), wid = __builtin_amdgcn_readfirstlane(tid >> 6), lane = tid & 63, wr = wid >> 2, wc = wid & 3, fr = lane & 15, fq = lane >> 4;
    const int K = g.K, nt = K / BK;
    unsigned voffA[2], voffB[2];
#pragma unroll
    for (int i = 0; i < 2; ++i) { int R, C; stage_rc(tid * 16 + i * 8192, R, C); const int Rb = Epi::PERM ? ((R & ~31) + perm32(R & 31)) : R;
        voffA[i] = (unsigned)(R * g.lda + C) * 2u; voffB[i] = (unsigned)(Rb * g.ldb + C) * 2u; }
    const size_t kstep = (size_t)(BK * 2);
    const size_t hstepA = (size_t)HALF * g.lda * 2, hstepB = (size_t)HALF * g.ldb * 2;
    const size_t tstepA = 2 * hstepA, tstepB = 2 * hstepB;
    const unsigned ldsw = (unsigned)wid * 1024u;
    const int aoff = lds_byte(wr * 64 + fr, fq * 8), boff = lds_byte(wc * 32 + fr, fq * 8);
#define PG8_SA(b, h) (((b) * 2 + (h)) * HTB)
#define PG8_SB(b, h) ((4 + (b) * 2 + (h)) * HTB)
#define PG8_STAGE(bufoff, gbase, voff) do { _Pragma("unroll") for (int _i = 0; _i < 2; ++_i) \
        __builtin_amdgcn_global_load_lds((const unsigned*)((const char*)(gbase) + (voff)[_i]), (LAS unsigned*)(lds + (bufoff) + ldsw + _i * 8192), 16, 0, 0); } while (0)
#define PG8_LDA(dst, b, h) do { _Pragma("unroll") for (int m = 0; m < 4; ++m) _Pragma("unroll") for (int k = 0; k < 2; ++k) dst[m][k] = *(const LAS bf16x8*)(lds + PG8_SA(b, h) + aoff + m * 2048 + k * 1024); } while (0)
#define PG8_LDB(dst, b, h) do { _Pragma("unroll") for (int n = 0; n < 2; ++n) _Pragma("unroll") for (int k = 0; k < 2; ++k) dst[n][k] = *(const LAS bf16x8*)(lds + PG8_SB(b, h) + boff + n * 2048 + k * 1024); } while (0)
#define PG8_MMA(ai, bj, At, Bt) do { __builtin_amdgcn_s_setprio(1); _Pragma("unroll") for (int m = 0; m < 4; ++m) _Pragma("unroll") for (int n = 0; n < 2; ++n) _Pragma("unroll") for (int k = 0; k < 2; ++k) \
        acc[ai][bj][m][n] = __builtin_amdgcn_mfma_f32_16x16x32_bf16(Bt[n][k], At[m][k], acc[ai][bj][m][n], 0, 0, 0); __builtin_amdgcn_s_setprio(0); } while (0)
#define PG8_WAIT_V(n) asm volatile("s_waitcnt vmcnt(" #n ")" ::: "memory")
#define PG8_WAIT_L(n) asm volatile("s_waitcnt lgkmcnt(" #n ")" ::: "memory")
#define PG8_BAR __builtin_amdgcn_s_barrier()
#define PG8_SCHED __builtin_amdgcn_sched_barrier(0)
#define PG8_APTR(u) ((const char*)g.A + (size_t)(g.a_local ? (u).lt : (u).pm) * tstepA + (g.grouped ? (size_t)(u).pn * K * 2 : (size_t)0))
#define PG8_BPTR(u) ((const char*)g.Bt + (size_t)(u).pn * tstepB)
    Unit cur, nxt; int ui = 0;
    if (!S.next(0, cur)) return;
    f32x4 acc[2][2][4][2];
#pragma unroll
    for (int a = 0; a < 2; ++a)
#pragma unroll
        for (int b = 0; b < 2; ++b)
#pragma unroll
            for (int m = 0; m < 4; ++m)
#pragma unroll
                for (int n = 0; n < 2; ++n) acc[a][b][m][n] = (f32x4){0.f, 0.f, 0.f, 0.f};
    bf16x8 At[4][2], B0[2][2], B1[2][2];
    const char* cA = PG8_APTR(cur); const char* cB = PG8_BPTR(cur);
    PG8_STAGE(PG8_SB(0, 0), cB, voffB); PG8_STAGE(PG8_SB(0, 1), cB + hstepB, voffB); PG8_STAGE(PG8_SA(0, 0), cA, voffA); PG8_STAGE(PG8_SA(0, 1), cA + hstepA, voffA);
    if (wr == 1) PG8_BAR;
    PG8_WAIT_V(2); PG8_BAR;
    PG8_STAGE(PG8_SB(1, 0), cB + kstep, voffB); PG8_STAGE(PG8_SA(1, 0), cA + kstep, voffA); PG8_STAGE(PG8_SB(1, 1), cB + hstepB + kstep, voffB);
    PG8_WAIT_V(6); PG8_BAR;
    for (;;) {
        const bool has_next = S.next(ui + 1, nxt);
        const char* nA = has_next ? PG8_APTR(nxt) : cA; const char* nB = has_next ? PG8_BPTR(nxt) : cB;
        for (int t = 0; t < nt; t += 2) {
            const bool last = (t == nt - 2);
            const char* a1 = cA + (size_t)(t + 1) * kstep;
            const char* a2 = last ? nA : cA + (size_t)(t + 2) * kstep; const char* b2 = last ? nB : cB + (size_t)(t + 2) * kstep;
            const char* a3 = a2 + kstep; const char* b3 = b2 + kstep;
            PG8_LDB(B0, 0, 0); PG8_LDB(B1, 0, 1); PG8_SCHED; PG8_LDA(At, 0, 0); PG8_STAGE(PG8_SA(1, 1), a1 + hstepA, voffA);
            PG8_WAIT_V(8); PG8_WAIT_L(0); PG8_BAR; PG8_MMA(0, 0, At, B0); PG8_MMA(0, 1, At, B1); PG8_BAR; PG8_SCHED;
            PG8_LDA(At, 0, 1); PG8_STAGE(PG8_SB(0, 0), b2, voffB); PG8_STAGE(PG8_SB(0, 1), b2 + hstepB, voffB); PG8_STAGE(PG8_SA(0, 0), a2, voffA);
            PG8_WAIT_V(8); PG8_WAIT_L(0); PG8_BAR; PG8_MMA(1, 0, At, B0); PG8_MMA(1, 1, At, B1); PG8_BAR; PG8_SCHED;
            PG8_LDB(B0, 1, 0); PG8_LDB(B1, 1, 1); PG8_SCHED; PG8_LDA(At, 1, 0); PG8_STAGE(PG8_SA(0, 1), a2 + hstepA, voffA);
            PG8_WAIT_V(8); PG8_WAIT_L(0); PG8_BAR; PG8_MMA(0, 0, At, B0); PG8_MMA(0, 1, At, B1); PG8_BAR; PG8_SCHED;
            PG8_LDA(At, 1, 1); PG8_STAGE(PG8_SB(1, 0), b3, voffB); PG8_STAGE(PG8_SB(1, 1), b3 + hstepB, voffB); PG8_STAGE(PG8_SA(1, 0), a3, voffA);
            PG8_WAIT_V(8); PG8_WAIT_L(0); PG8_BAR; PG8_MMA(1, 0, At, B0); PG8_MMA(1, 1, At, B1); PG8_BAR; PG8_SCHED;
        }
        if (wr == 0) PG8_BAR;
        E(acc, cur, wr, wc, fr, fq);
        if (!has_next) break;
#pragma unroll
        for (int a = 0; a < 2; ++a)
#pragma unroll
            for (int b = 0; b < 2; ++b)
#pragma unroll
                for (int m = 0; m < 4; ++m)
#pragma unroll
                    for (int n = 0; n < 2; ++n) acc[a][b][m][n] = (f32x4){0.f, 0.f, 0.f, 0.f};
        cur = nxt; cA = nA; cB = nB; ++ui;
        if (wr == 1) PG8_BAR;
    }
    PG8_WAIT_V(0);
    PG8_BAR;
#undef PG8_SA
#undef PG8_SB
#undef PG8_STAGE
#undef PG8_LDA
#undef PG8_LDB
#undef PG8_MMA
#undef PG8_WAIT_V
#undef PG8_WAIT_L
#undef PG8_BAR
#undef PG8_SCHED
#undef PG8_APTR
#undef PG8_BPTR
}

typedef f32x4 Acc[2][2][4][2];

struct EpiResid {
    static constexpr bool PERM = false;
    const float* base_l; const float* base_c; float* out_l; float* out_c; const float* gate; const float* colscale;
    DI void operator()(const Acc& acc, const Unit& u, int wr, int wc, int fr, int fq) const {
        const bool lat = u.pm < 256; const int bb = lat ? (u.pm >> 5) : 8;
        const size_t rowt = lat ? (size_t)u.pm * 256 : (size_t)(u.pm - 256) * 256;
        const float* bp = (lat ? base_l : base_c) + rowt * DM; float* op = (lat ? out_l : out_c) + rowt * DM;
        const float* gp = gate + bb * MODW;
        const int col0 = u.pn * 256 + wc * 32 + 4 * fq;
#pragma unroll
        for (int bj = 0; bj < 2; ++bj)
#pragma unroll
            for (int n = 0; n < 2; ++n) {
                const int c = col0 + bj * 128 + n * 16;
                f32x4 gv = *(const f32x4*)(gp + c);
                if (colscale) gv = gv * *(const f32x4*)(colscale + c);
#pragma unroll
                for (int ai = 0; ai < 2; ++ai) {
                    const int frx = opq(fr);
#pragma unroll
                    for (int m = 0; m < 4; ++m) {
                        const size_t off = (size_t)(ai * 128 + wr * 64 + m * 16 + frx) * DM + c;
                        const f32x4 o = *(const f32x4*)(bp + off) + acc[ai][bj][m][n] * gv;
                        *(f32x4*)(op + off) = o;
                    }
                    asm volatile("" ::: "memory");
                }
            }
    }
};

struct EpiSwiGLU {
    static constexpr bool PERM = true;
    bf16_t* HID;
    DI void operator()(const Acc& acc, const Unit& u, int wr, int wc, int fr, int fq) const {
        const int hc0 = u.pn * 128 + wc * 32 + 8 * fq;
#pragma unroll
        for (int ai = 0; ai < 2; ++ai)
#pragma unroll
            for (int m = 0; m < 4; ++m) {
                const f32x4 g0 = acc[ai][0][m][0], g1 = acc[ai][0][m][1], u0 = acc[ai][1][m][0], u1 = acc[ai][1][m][1];
                const size_t row0 = (size_t)u.pm * 256 + wr * 64 + opq(fr);
                u32x4 w;
                w.x = pk2(silu_f(g0[0]) * u0[0], silu_f(g0[1]) * u0[1]); w.y = pk2(silu_f(g0[2]) * u0[2], silu_f(g0[3]) * u0[3]);
                w.z = pk2(silu_f(g1[0]) * u1[0], silu_f(g1[1]) * u1[1]); w.w = pk2(silu_f(g1[2]) * u1[2], silu_f(g1[3]) * u1[3]);
                *(u32x4*)(HID + (row0 + ai * 128 + m * 16) * FFH + hc0) = w;
                asm volatile("" ::: "memory");
            }
    }
};

struct EpiAttnQKV {
    static constexpr bool PERM = true;
    bf16_t* QKV; const float* qg; const float* kg; const float* cosT; const float* sinT;
    DI void operator()(const Acc& acc, const Unit& u, int wr, int wc, int fr, int fq) const {
        const int mode = u.pn < 4 ? 0 : (u.pn == 4 ? 1 : 2);
        const bool lat = u.pm < 256; const int tok0 = (u.pm * 256) & (SEQ - 1);
        const int jb = 8 * fq;
        const float* gp = mode == 0 ? qg : kg;
        f32x4 gn[2][2];
#pragma unroll
        for (int bj = 0; bj < 2; ++bj)
#pragma unroll
            for (int n = 0; n < 2; ++n) gn[bj][n] = *(const f32x4*)(gp + 32 * bj + jb + 4 * n);
        const int outcol = (mode == 0 ? u.pn * 256 : (mode == 1 ? 1024 : 1280)) + wc * 64 + jb;
#pragma unroll
        for (int ai = 0; ai < 2; ++ai)
#pragma unroll
            for (int m = 0; m < 4; ++m) {
                const int rl = ai * 128 + wr * 64 + m * 16 + opq(fr);
                f32x4 v[2][2];
#pragma unroll
                for (int bj = 0; bj < 2; ++bj)
#pragma unroll
                    for (int n = 0; n < 2; ++n) v[bj][n] = acc[ai][bj][m][n];
                if (mode < 2) {
                    float ss = 0.f;
#pragma unroll
                    for (int bj = 0; bj < 2; ++bj)
#pragma unroll
                        for (int n = 0; n < 2; ++n) { const f32x4 x = v[bj][n]; ss += (x[0] * x[0] + x[1] * x[1]) + (x[2] * x[2] + x[3] * x[3]); }
                    { const int ln = fr + 16 * fq; ss += shx(ss, 16, ln); ss += shx(ss, 32, ln); }
                    float rs = rsqrtf(ss * (1.0f / 64.0f) + NEPS); if (mode == 0) rs *= 0.125f;
#pragma unroll
                    for (int bj = 0; bj < 2; ++bj)
#pragma unroll
                        for (int n = 0; n < 2; ++n) v[bj][n] = v[bj][n] * rs * gn[bj][n];
                    if (lat) {
                        const int t = tok0 + rl;
#pragma unroll
                        for (int n = 0; n < 2; ++n) {
                            const f32x4 cs = *(const f32x4*)(cosT + t * 32 + jb + 4 * n), sn = *(const f32x4*)(sinT + t * 32 + jb + 4 * n);
                            const f32x4 x1 = v[0][n], x2 = v[1][n];
                            v[0][n] = x1 * cs - x2 * sn; v[1][n] = x2 * cs + x1 * sn;
                        }
                    }
                }
                bf16_t* rp = QKV + ((size_t)u.pm * 256 + rl) * 1536 + outcol;
#pragma unroll
                for (int bj = 0; bj < 2; ++bj) {
                    u32x4 w; w.x = pk2(v[bj][0][0], v[bj][0][1]); w.y = pk2(v[bj][0][2], v[bj][0][3]); w.z = pk2(v[bj][1][0], v[bj][1][1]); w.w = pk2(v[bj][1][2], v[bj][1][3]);
                    *(u32x4*)(rp + 32 * bj) = w;
                }
                asm volatile("" ::: "memory");
            }
    }
};

struct EpiRetQKV {
    static constexpr bool PERM = true;
    bf16_t* RQKV; const float* cosT; const float* sinT;
    DI void operator()(const Acc& acc, const Unit& u, int wr, int wc, int fr, int fq) const {
        const bool lat = u.pm < 256; const int tok0 = (u.pm * 256) & (SEQ - 1);
        const int j0 = 32 * wc + 8 * fq;
        const float sc = (u.pn >= 4 && u.pn < 8) ? 0.0625f : 1.0f;
#pragma unroll
        for (int ai = 0; ai < 2; ++ai)
#pragma unroll
            for (int m = 0; m < 4; ++m) {
                const int rl = ai * 128 + wr * 64 + m * 16 + opq(fr);
                f32x4 v[2][2];
#pragma unroll
                for (int bj = 0; bj < 2; ++bj)
#pragma unroll
                    for (int n = 0; n < 2; ++n) v[bj][n] = acc[ai][bj][m][n] * sc;
                if (u.pn < 8 && lat) {
                    const int t = tok0 + rl;
#pragma unroll
                    for (int n = 0; n < 2; ++n) {
                        const f32x4 cs = *(const f32x4*)(cosT + t * 128 + j0 + 4 * n), sn = *(const f32x4*)(sinT + t * 128 + j0 + 4 * n);
                        const f32x4 x1 = v[0][n], x2 = v[1][n];
                        v[0][n] = x1 * cs - x2 * sn; v[1][n] = x2 * cs + x1 * sn;
                    }
                }
                bf16_t* rp = RQKV + ((size_t)u.lt * 256 + rl) * 4096 + u.pn * 256 + j0;
#pragma unroll
                for (int bj = 0; bj < 2; ++bj) {
                    u32x4 w; w.x = pk2(v[bj][0][0], v[bj][0][1]); w.y = pk2(v[bj][0][2], v[bj][0][3]); w.z = pk2(v[bj][1][0], v[bj][1][1]); w.w = pk2(v[bj][1][2], v[bj][1][3]);
                    *(u32x4*)(rp + 128 * bj) = w;
                }
                asm volatile("" ::: "memory");
            }
    }
};

struct EpiRetGate {
    static constexpr bool PERM = true;
    const bf16_t* YF; const bf16_t* YB; const float* SS; bf16_t* Z;
    DI void operator()(const Acc& acc, const Unit& u, int wr, int wc, int fr, int fq) const {
        const int c0 = u.pn * 128 + 32 * wc + 8 * fq, head = u.pn >> 2;
#pragma unroll
        for (int ai = 0; ai < 2; ++ai)
#pragma unroll
            for (int m = 0; m < 4; ++m) {
                const size_t lrow = (size_t)u.lt * 256 + ai * 128 + wr * 64 + m * 16 + opq(fr);
                const float* sp = SS + ((lrow * 4 + head) * 2) * 16;
                float sf = 0.f, sb = 0.f;
#pragma unroll
                for (int q = 0; q < 4; ++q) { const f32x4 a = *(const f32x4*)(sp + 4 * q), b = *(const f32x4*)(sp + 16 + 4 * q); sf += (a[0] + a[1]) + (a[2] + a[3]); sb += (b[0] + b[1]) + (b[2] + b[3]); }
                const float rf = rsqrtf(sf * (1.0f / 512.0f) + NEPS), rb = rsqrtf(sb * (1.0f / 512.0f) + NEPS);
                const u32x4 yf = *(const u32x4*)(YF + lrow * 2048 + c0), yb = *(const u32x4*)(YB + lrow * 2048 + c0);
                const f32x4 f0 = acc[ai][0][m][0], f1 = acc[ai][0][m][1], b0 = acc[ai][1][m][0], b1 = acc[ai][1][m][1];
                u32x4 w;
                w.x = pk2(silu_f(f0[0]) * bflo(yf.x) * rf + silu_f(b0[0]) * bflo(yb.x) * rb, silu_f(f0[1]) * bfhi(yf.x) * rf + silu_f(b0[1]) * bfhi(yb.x) * rb);
                w.y = pk2(silu_f(f0[2]) * bflo(yf.y) * rf + silu_f(b0[2]) * bflo(yb.y) * rb, silu_f(f0[3]) * bfhi(yf.y) * rf + silu_f(b0[3]) * bfhi(yb.y) * rb);
                w.z = pk2(silu_f(f1[0]) * bflo(yf.z) * rf + silu_f(b1[0]) * bflo(yb.z) * rb, silu_f(f1[1]) * bfhi(yf.z) * rf + silu_f(b1[1]) * bfhi(yb.z) * rb);
                w.w = pk2(silu_f(f1[2]) * bflo(yf.w) * rf + silu_f(b1[2]) * bflo(yb.w) * rb, silu_f(f1[3]) * bfhi(yf.w) * rf + silu_f(b1[3]) * bfhi(yb.w) * rb);
                *(u32x4*)(Z + lrow * 2048 + c0) = w;
                asm volatile("" ::: "memory");
            }
    }
};
}

struct Params {
    const float* x; const float* c; const float* ctx; const float* c_ctx; const float* ada_w; const float* ada_b; const float* norm_mix; const float* norm_ffn;
    const float* attn_w_qkv; const float* attn_w_o; const float* attn_q_norm; const float* attn_k_norm; const float* attn_sink;
    const float* pool_w; const float* pool_scale; const float* ret_w_in; const float* ret_w_o; const float* ffn_w_gate; const float* ffn_w_up; const float* ffn_w_down;
    float* out; unsigned char* ws;
};

DI void transpose_item(const float* W, int ldw, int k0, int col0, bf16_t* dst, int ldd, int drow0, LAS float* scr, int lane) {
#pragma unroll 8
    for (int i = 0; i < 32; ++i) { const int kk = 2 * i + (lane >> 5); scr[kk * 33 + (lane & 31)] = W[(size_t)(k0 + kk) * ldw + col0 + (lane & 31)]; }
    asm volatile("s_waitcnt lgkmcnt(0)" ::: "memory");
    const int c = lane & 7;
#pragma unroll
    for (int j = 0; j < 4; ++j) { const int n = (lane >> 3) + 8 * j; const LAS float* s = scr + (8 * c) * 33 + n;
        u32x4 o; o.x = pk2(s[0 * 33], s[1 * 33]); o.y = pk2(s[2 * 33], s[3 * 33]); o.z = pk2(s[4 * 33], s[5 * 33]); o.w = pk2(s[6 * 33], s[7 * 33]);
        *(u32x4*)(dst + (size_t)(drow0 + n) * ldd + k0 + 8 * c) = o; }
    asm volatile("s_waitcnt lgkmcnt(0)" ::: "memory");
}
DI int dst_row_of(int kind, int n0) {
    if (kind == 0) return n0;
    if (kind == 1) return (n0 & ~255) + 128 * ((n0 >> 5) & 1) + 32 * ((n0 >> 6) & 3);
    return 256 * (n0 >> 7) + (n0 & 127) + (kind == 3 ? 128 : 0);
}
DI void transpose_matrix(const float* W, int K, int ldw, int col_off, int ncols, bf16_t* dst, int ldd, int drow_off, int kind, LAS float* scr, int lane, int gw, int NGW, int& cnt) {
    const int nblk = ncols / 32, nitems = (K / 64) * nblk;
    int first = (gw - (cnt % NGW) + NGW) % NGW;
    for (int it = first; it < nitems; it += NGW) {
        const int kb = it / nblk, nb = it % nblk;
        transpose_item(W, ldw, 64 * kb, col_off + 32 * nb, dst, ldd, drow_off + dst_row_of(kind, 32 * nb), scr, lane);
    }
    cnt += nitems;
}

DI void prenorm_phase(const float* xl, const float* xc, const float* gain, const float* modl, int shi, int sci, bf16_t* H, int G, int bid, int wid0) {
    const int tid = opaque_tid(wid0), lane = tid & 63, gw = bid * 8 + __builtin_amdgcn_readfirstlane(tid >> 6), NGW = G * 8;
    constexpr int RW = 4;
    for (int row0 = gw * RW; row0 < MTOT; row0 += NGW * RW) {
        const bool lat = row0 < MLAT; const int bb = lat ? (row0 >> 13) : 8;
        const float* src = lat ? xl + (size_t)row0 * DM : xc + (size_t)(row0 - MLAT) * DM;
        const float* mp = modl + bb * MODW;
        f32x4 v[RW][4]; float s[RW];
#pragma unroll
        for (int q = 0; q < RW; ++q) {
            s[q] = 0.f;
#pragma unroll
            for (int j = 0; j < 4; ++j) v[q][j] = *(const f32x4*)(src + (size_t)q * DM + 256 * j + 4 * lane);
        }
#pragma unroll
        for (int q = 0; q < RW; ++q)
#pragma unroll
            for (int j = 0; j < 4; ++j) s[q] += (v[q][j][0] * v[q][j][0] + v[q][j][1] * v[q][j][1]) + (v[q][j][2] * v[q][j][2] + v[q][j][3] * v[q][j][3]);
#pragma unroll
        for (int o = 1; o < 64; o <<= 1)
#pragma unroll
            for (int q = 0; q < RW; ++q) s[q] += shx(s[q], o, lane);
#pragma unroll
        for (int j = 0; j < 4; ++j) {
            const int col = 256 * j + 4 * lane;
            const f32x4 g = *(const f32x4*)(gain + col), sc = *(const f32x4*)(mp + sci * DM + col), sh = *(const f32x4*)(mp + shi * DM + col);
            const f32x4 gs = g * (sc + 1.0f);
#pragma unroll
            for (int q = 0; q < RW; ++q) {
                const float rstd = rsqrtf(s[q] * (1.0f / DM) + NEPS);
                const f32x4 o = v[q][j] * rstd * gs + sh;
                u32x2 w; w.x = pk2(o[0], o[1]); w.y = pk2(o[2], o[3]);
                *(u32x2*)(H + (size_t)(row0 + q) * DM + col) = w;
            }
        }
    }
}
DI void pool_phase(const bf16_t* H, bf16_t* P, int G, int bid, int wid0) {
    const int gtid = bid * 512 + opaque_tid(wid0), NT = G * 512;
    for (int it = gtid; it < MTOT * 128; it += NT) {
        const int row = it >> 7, c8 = (it & 127) * 8;
        const int grp = c8 >> 8, hw = 1 << grp;
        int t, T, rbase;
        if (row < MLAT) { t = row & (SEQ - 1); T = SEQ; rbase = row - t; } else { t = (row - MLAT) & (CTXL - 1); T = CTXL; rbase = row - t; }
        const int lo = t - hw < 0 ? 0 : t - hw, hi = t + hw > T ? T : t + hw;
        float a[8];
#pragma unroll
        for (int e = 0; e < 8; ++e) a[e] = 0.f;
        for (int tt = lo; tt < hi; ++tt) {
            const u32x4 w = *(const u32x4*)(H + (size_t)(rbase + tt) * DM + c8);
            a[0] += bflo(w.x); a[1] += bfhi(w.x); a[2] += bflo(w.y); a[3] += bfhi(w.y); a[4] += bflo(w.z); a[5] += bfhi(w.z); a[6] += bflo(w.w); a[7] += bfhi(w.w);
        }
        const float inv = 1.0f / (float)(hi - lo);
        const u32x4 w = *(const u32x4*)(H + (size_t)row * DM + c8);
        u32x4 o;
        o.x = pk2(a[0] * inv - bflo(w.x), a[1] * inv - bfhi(w.x)); o.y = pk2(a[2] * inv - bflo(w.y), a[3] * inv - bfhi(w.y));
        o.z = pk2(a[4] * inv - bflo(w.z), a[5] * inv - bfhi(w.z)); o.w = pk2(a[6] * inv - bflo(w.w), a[7] * inv - bfhi(w.w));
        *(u32x4*)(P + (size_t)row * DM + c8) = o;
    }
}

constexpr int AT_KOFF = 0, AT_VOFF = 128 * 144, AT_PITCH = 144;
DI void attn_phase(LAS unsigned char* lds, const bf16_t* QKV, bf16_t* AO, const float* sink, bool do_ctx, int G, int bid, int wid0) {
    const int tid = opaque_tid(wid0), lane = tid & 63, wid = __builtin_amdgcn_readfirstlane(tid >> 6);
    const int r = lane & 31, hh = lane >> 5, i16 = lane & 15, q4 = i16 >> 2, p4 = i16 & 3, blk = (lane >> 4) & 1;
    const int nunits = 2048 + (do_ctx ? 64 : 0);
    for (int u = bid; u < nunits; u += G) {
        int b, kvh, qb; bool isctx;
        if (u < 2048) { b = u >> 8; kvh = (u >> 6) & 3; qb = u & 63; isctx = false; } else { const int v = u - 2048; b = v >> 3; kvh = (v >> 1) & 3; qb = v & 1; isctx = true; }
        const size_t qrow0 = isctx ? (size_t)(MLAT + b * CTXL + qb * 128) : (size_t)(b * SEQ + qb * 128);
        const int g = wid >> 1, qh = wid & 1, head = kvh * 4 + g;
        bf16x8 qf[2][4];
#pragma unroll
        for (int qt = 0; qt < 2; ++qt)
#pragma unroll
            for (int s = 0; s < 4; ++s) qf[qt][s] = *(const bf16x8*)(QKV + (qrow0 + qh * 64 + qt * 32 + r) * 1536 + head * 64 + 16 * s + 8 * hh);
        f32x16 o[2][2]; float l[2] = {0.f, 0.f};
#pragma unroll
        for (int a = 0; a < 2; ++a)
#pragma unroll
            for (int c = 0; c < 2; ++c)
#pragma unroll
                for (int e = 0; e < 16; ++e) o[a][c][e] = 0.f;
        for (int c = 0; c < 5; ++c) {
            size_t krow0; bool local;
            if (c < 3) { if (isctx) continue; const int kb = qb - 1 + c; if (kb < 0 || kb > 63) continue; krow0 = (size_t)(b * SEQ + kb * 128); local = true; }
            else { krow0 = (size_t)(MLAT + b * CTXL + (c - 3) * 128); local = false; }
            __syncthreads();
#pragma unroll
            for (int i = 0; i < 2; ++i) {
                const int p = tid + 512 * i, row = p >> 3, ch = p & 7;
                const u32x4 kv = *(const u32x4*)(QKV + (krow0 + row) * 1536 + 1024 + kvh * 64 + ch * 8);
                const u32x4 vv = *(const u32x4*)(QKV + (krow0 + row) * 1536 + 1280 + kvh * 64 + ch * 8);
                *(LAS u32x4*)(lds + AT_KOFF + row * AT_PITCH + ch * 16) = kv;
                *(LAS u32x4*)(lds + AT_VOFF + row * AT_PITCH + ch * 16) = vv;
            }
            __syncthreads();
            const int relbase = (c - 1) * 128;
#pragma unroll 1
            for (int kb32 = 0; kb32 < 4; ++kb32) {
                bf16x8 kf[4];
#pragma unroll
                for (int s = 0; s < 4; ++s) kf[s] = *(const LAS bf16x8*)(lds + AT_KOFF + (kb32 * 32 + r) * AT_PITCH + (16 * s + 8 * hh) * 2);
                bf16x8 vf[2][2];
#pragma unroll
                for (int dt = 0; dt < 2; ++dt)
#pragma unroll
                    for (int s2 = 0; s2 < 2; ++s2) {
                        const LAS unsigned char* vp = lds + AT_VOFF + (kb32 * 32 + 16 * s2 + 4 * hh + q4) * AT_PITCH + (dt * 32 + 16 * blk) * 2 + 8 * p4;
                        vf[dt][s2] = cat8(trd(vp), trd(vp + 8 * AT_PITCH));
                    }
#pragma unroll
                for (int qt = 0; qt < 2; ++qt) {
                    f32x16 sa;
#pragma unroll
                    for (int e = 0; e < 16; ++e) sa[e] = 0.f;
#pragma unroll
                    for (int s = 0; s < 4; ++s) sa = MFMA32(kf[s], qf[qt][s], sa);
                    const int qi = qh * 64 + qt * 32 + r;
                    float ls = 0.f;
#pragma unroll
                    for (int e = 0; e < 16; ++e) {
                        float p = __expf(sa[e]);
                        if (local) { const int rel = relbase + kb32 * 32 + crow(e, hh) - qi; if (rel > 128 || rel < -128) p = 0.f; }
                        sa[e] = p; ls += p;
                    }
                    l[qt] += ls;
                    const bf16x8 p0 = pack8(sa, 0), p1 = pack8(sa, 1);
#pragma unroll
                    for (int dt = 0; dt < 2; ++dt) { o[dt][qt] = MFMA32(vf[dt][0], p0, o[dt][qt]); o[dt][qt] = MFMA32(vf[dt][1], p1, o[dt][qt]); }
                }
            }
        }
        const float es = __expf(sink[head]);
#pragma unroll
        for (int qt = 0; qt < 2; ++qt) {
            const float lt = l[qt] + shx(l[qt], 32, lane) + es;
            const float inv = 1.0f / lt;
            bf16_t* op = AO + (qrow0 + qh * 64 + qt * 32 + r) * DM + head * 64;
#pragma unroll
            for (int dt = 0; dt < 2; ++dt)
#pragma unroll
                for (int g4 = 0; g4 < 4; ++g4) {
                    u32x2 w; w.x = pk2(o[dt][qt][4 * g4] * inv, o[dt][qt][4 * g4 + 1] * inv); w.y = pk2(o[dt][qt][4 * g4 + 2] * inv, o[dt][qt][4 * g4 + 3] * inv);
                    *(u32x2*)(op + dt * 32 + 8 * g4 + 4 * hh) = w;
                }
        }
    }
}

DI float ret_log2g(int h, int dir) { return log2f(1.0f - exp2f(-5.0f - (dir ? 0.5f : 0.0f) - (float)h)); }
constexpr int RI_PITCH = 1040;
DI void ret_intra_phase(LAS unsigned char* lds, const bf16_t* RQKV, bf16_t* YF, bf16_t* YB, int G, int bid, int wid0) {
    const int tid = opaque_tid(wid0), lane = tid & 63, wid = __builtin_amdgcn_readfirstlane(tid >> 6);
    const int r = lane & 31, hh = lane >> 5, i16 = lane & 15, q4 = i16 >> 2, p4 = i16 & 3, blk = (lane >> 4) & 1;
    const int it = wid & 3, dir = wid >> 2;
    for (int u = bid; u < 1056; u += G) {
        const int b4 = u / 264, rem = u % 264, h = rem / 66, ch = rem % 66;
        const size_t lrow0 = ch < 64 ? (size_t)(b4 * SEQ + ch * 128) : (size_t)(4 * SEQ + b4 * CTXL + (ch - 64) * 128);
        __syncthreads();
#pragma unroll 4
        for (int i = 0; i < 16; ++i) {
            const int p = tid + 512 * i, row = p >> 6, cn = p & 63;
            *(LAS u32x4*)(lds + row * RI_PITCH + cn * 16) = *(const u32x4*)(RQKV + (lrow0 + row) * 4096 + 2048 + h * 512 + cn * 8);
        }
        const bf16_t* qp = RQKV + (lrow0 + it * 32 + r) * 4096 + h * 256 + 8 * hh;
        const float l2g = ret_log2g(h, dir);
        bf16x8 pf[4][2];
#pragma unroll
        for (int jt = 0; jt < 4; ++jt) {
            const bool need = dir == 0 ? (jt <= it) : (jt >= it);
            if (need) {
                f32x16 sa;
#pragma unroll
                for (int e = 0; e < 16; ++e) sa[e] = 0.f;
                const bf16_t* kp = RQKV + (lrow0 + jt * 32 + r) * 4096 + 1024 + h * 256 + 8 * hh;
#pragma unroll 8
                for (int s = 0; s < 16; ++s) {
                    const bf16x8 kf = *(const bf16x8*)(kp + 16 * s);
                    sa = MFMA32(kf, *(const bf16x8*)(qp + 16 * s), sa);
                }
                const int i = it * 32 + r;
#pragma unroll
                for (int e = 0; e < 16; ++e) {
                    const int j = jt * 32 + crow(e, hh); const int diff = dir == 0 ? i - j : j - i;
                    sa[e] = diff >= 0 ? sa[e] * exp2f((float)diff * l2g) : 0.f;
                }
                pf[jt][0] = pack8(sa, 0); pf[jt][1] = pack8(sa, 1);
            } else { pf[jt][0] = (bf16x8){0, 0, 0, 0, 0, 0, 0, 0}; pf[jt][1] = pf[jt][0]; }
        }
        __syncthreads();
        bf16_t* Y = (dir ? YB : YF) + (lrow0 + it * 32 + r) * 2048 + h * 512;
#pragma unroll 1
        for (int vt = 0; vt < 16; ++vt) {
            f32x16 acc;
#pragma unroll
            for (int e = 0; e < 16; ++e) acc[e] = 0.f;
#pragma unroll
            for (int jt = 0; jt < 4; ++jt) {
                const bool need = dir == 0 ? (jt <= it) : (jt >= it);
                if (need) {
#pragma unroll
                    for (int s2 = 0; s2 < 2; ++s2) {
                        const LAS unsigned char* vp = lds + (jt * 32 + 16 * s2 + 4 * hh + q4) * RI_PITCH + (vt * 32 + 16 * blk) * 2 + 8 * p4;
                        acc = MFMA32(cat8(trd(vp), trd(vp + 8 * RI_PITCH)), pf[jt][s2], acc);
                    }
                }
            }
#pragma unroll
            for (int g4 = 0; g4 < 4; ++g4) {
                u32x2 w; w.x = pk2(acc[4 * g4], acc[4 * g4 + 1]); w.y = pk2(acc[4 * g4 + 2], acc[4 * g4 + 3]);
                *(u32x2*)(Y + vt * 32 + 8 * g4 + 4 * hh) = w;
            }
        }
    }
}

constexpr int RS_KS = 0, RS_KP = 528, RS_VS = 128 * 528, RS_VP = 144, RS_ST = RS_VS + 128 * 144, RS_SP = 528;
DI size_t rs_row0(int step, int dir, int b4) {
    const int ch = dir == 0 ? (step < 2 ? 64 + step : step - 2) : 65 - step;
    return ch < 64 ? (size_t)(b4 * SEQ + ch * 128) : (size_t)(4 * SEQ + b4 * CTXL + (ch - 64) * 128);
}
DI void ret_scan_phase(LAS unsigned char* lds, const bf16_t* RQKV, bf16_t* YF, bf16_t* YB, float* SS, int G, int bid, int wid0) {
    const int tid = opaque_tid(wid0), lane = tid & 63, wid = __builtin_amdgcn_readfirstlane(tid >> 6);
    const int r = lane & 31, hh = lane >> 5, i16 = lane & 15, q4 = i16 >> 2, p4 = i16 & 3, blk = (lane >> 4) & 1;
    const int vta = wid >> 2, ita = wid & 3;
    for (int item0 = bid; item0 < 256; item0 += G) {
        int item = item0;
        if (G == 256) { const int xcd = item0 & 7, idx = item0 >> 3; item = ((xcd * 4 + (idx >> 3)) << 3) | (idx & 7); }
        const int sl = item & 7, dir = (item >> 3) & 1, h = (item >> 4) & 3, b4 = item >> 6;
        bf16_t* Y = dir ? YB : YF;
        const float l2g = ret_log2g(h, dir);
        f32x16 S[2];
#pragma unroll
        for (int e = 0; e < 16; ++e) { S[0][e] = 0.f; S[1][e] = 0.f; }
        __syncthreads();
        for (int i = tid; i < 64 * RS_SP / 4; i += 512) *(LAS unsigned*)(lds + RS_ST + 4 * i) = 0u;
        const float cdec = exp2f(l2g * 128.0f);
        const int krow = tid >> 5, kc16 = tid & 31, vrow = tid >> 3, vc16 = tid & 7;
        u32x4 kreg[8], vreg[2];
        {
            const size_t l0 = rs_row0(0, dir, b4);
#pragma unroll
            for (int i = 0; i < 8; ++i) kreg[i] = *(const u32x4*)(RQKV + (l0 + krow + 16 * i) * 4096 + 1024 + h * 256 + kc16 * 8);
#pragma unroll
            for (int i = 0; i < 2; ++i) vreg[i] = *(const u32x4*)(RQKV + (l0 + vrow + 64 * i) * 4096 + 2048 + h * 512 + sl * 64 + vc16 * 8);
        }
#pragma unroll 1
        for (int step = 0; step < 66; ++step) {
            const size_t lrow0 = rs_row0(step, dir, b4);
#pragma unroll
            for (int i = 0; i < 8; ++i) *(LAS u32x4*)(lds + RS_KS + (krow + 16 * i) * RS_KP + kc16 * 16) = kreg[i];
#pragma unroll
            for (int i = 0; i < 2; ++i) {
                const int row = vrow + 64 * i; const u32x4 w = vreg[i];
                const float kd = exp2f(l2g * (float)(dir ? row : 127 - row));
                u32x4 o; o.x = pk2(bflo(w.x) * kd, bfhi(w.x) * kd); o.y = pk2(bflo(w.y) * kd, bfhi(w.y) * kd); o.z = pk2(bflo(w.z) * kd, bfhi(w.z) * kd); o.w = pk2(bflo(w.w) * kd, bfhi(w.w) * kd);
                *(LAS u32x4*)(lds + RS_VS + row * RS_VP + vc16 * 16) = o;
            }
            const int i = ita * 32 + r;
            bf16x8 qf[16];
            {
                const bf16_t* qp = RQKV + (lrow0 + i) * 4096 + h * 256 + 8 * hh;
#pragma unroll
                for (int s = 0; s < 16; ++s) qf[s] = *(const bf16x8*)(qp + 16 * s);
            }
            bf16_t* yp = Y + (lrow0 + i) * 2048 + h * 512 + sl * 64 + vta * 32 + 4 * hh;
            u32x2 yi[4];
#pragma unroll
            for (int g4 = 0; g4 < 4; ++g4) yi[g4] = *(const u32x2*)(yp + 8 * g4);
            if (step + 1 < 66) {
                const size_t l1 = rs_row0(step + 1, dir, b4);
#pragma unroll
                for (int i2 = 0; i2 < 8; ++i2) kreg[i2] = *(const u32x4*)(RQKV + (l1 + krow + 16 * i2) * 4096 + 1024 + h * 256 + kc16 * 8);
#pragma unroll
                for (int i2 = 0; i2 < 2; ++i2) vreg[i2] = *(const u32x4*)(RQKV + (l1 + vrow + 64 * i2) * 4096 + 2048 + h * 512 + sl * 64 + vc16 * 8);
            }
            LDS_BARRIER();
            {
#pragma unroll
                for (int e = 0; e < 16; ++e) { S[0][e] *= cdec; S[1][e] *= cdec; }
#pragma unroll
                for (int s = 0; s < 8; ++s) {
                    const LAS unsigned char* kp = lds + RS_KS + (16 * s + 8 * hh + q4) * RS_KP + (wid * 32 + 16 * blk) * 2 + 8 * p4;
                    const bf16x8 ka = cat8(trd(kp), trd(kp + 4 * RS_KP));
#pragma unroll
                    for (int vt = 0; vt < 2; ++vt) {
                        const LAS unsigned char* vp = lds + RS_VS + (16 * s + 8 * hh + q4) * RS_VP + (vt * 32 + 16 * blk) * 2 + 8 * p4;
                        S[vt] = MFMA32(ka, cat8(trd(vp), trd(vp + 4 * RS_VP)), S[vt]);
                    }
                }
            }
            {
                f32x16 acc;
#pragma unroll
                for (int e = 0; e < 16; ++e) acc[e] = 0.f;
                const LAS unsigned char* sp = lds + RS_ST + (vta * 32 + r) * RS_SP + 16 * hh;
#pragma unroll
                for (int s = 0; s < 16; ++s) acc = MFMA32(*(const LAS bf16x8*)(sp + 32 * s), qf[s], acc);
                const float qd = exp2f(l2g * (float)(dir ? 128 - i : i + 1));
                float ssq = 0.f;
#pragma unroll
                for (int g4 = 0; g4 < 4; ++g4) {
                    const float y0 = acc[4 * g4] * qd + bflo(yi[g4].x), y1 = acc[4 * g4 + 1] * qd + bfhi(yi[g4].x), y2 = acc[4 * g4 + 2] * qd + bflo(yi[g4].y), y3 = acc[4 * g4 + 3] * qd + bfhi(yi[g4].y);
                    ssq += (y0 * y0 + y1 * y1) + (y2 * y2 + y3 * y3);
                    u32x2 w; w.x = pk2(y0, y1); w.y = pk2(y2, y3);
                    *(u32x2*)(yp + 8 * g4) = w;
                }
                ssq += shx(ssq, 32, lane);
                if (hh == 0) SS[(((lrow0 + i) * 4 + h) * 2 + dir) * 16 + sl * 2 + vta] = ssq;
            }
            LDS_BARRIER();
#pragma unroll
            for (int vt = 0; vt < 2; ++vt)
#pragma unroll
                for (int g4 = 0; g4 < 4; ++g4) {
                    u32x2 w; w.x = pk2(S[vt][4 * g4], S[vt][4 * g4 + 1]); w.y = pk2(S[vt][4 * g4 + 2], S[vt][4 * g4 + 3]);
                    *(LAS u32x2*)(lds + RS_ST + (vt * 32 + r) * RS_SP + (wid * 32 + 8 * g4 + 4 * hh) * 2) = w;
                }
        }
    }
}

#define XB_TMO      128
#define XB_XCNT(j)  (256  + 64 * (j))
#define XB_XSUB(j)  (1280 + 64 * (j))
#define XB_XGEN(j)  (2304 + 64 * (j))
#define XB_TOP      3328
#define XB_TOPGEN   3392
#define XCD_BAR_WORDS 3456
#define XB_SPIN_CAP (1u << 18)
DI unsigned xb_ld(unsigned* p)              { return __hip_atomic_load(p, __ATOMIC_RELAXED, __HIP_MEMORY_SCOPE_AGENT); }
DI unsigned xb_add(unsigned* p, unsigned v) { return __hip_atomic_fetch_add(p, v, __ATOMIC_RELAXED, __HIP_MEMORY_SCOPE_AGENT); }
DI unsigned xb_xcc_id() { return (unsigned)__builtin_amdgcn_s_getreg((3 << 11) | 20) & 0xFu; }
#define XB_SPIN(cond, bar) do { unsigned _sp = 0; while (cond) { __builtin_amdgcn_s_sleep(1); \
    if ((++_sp & 255u) == 0u) { if (xb_ld(&(bar)[XB_TMO])) break; if (_sp > XB_SPIN_CAP) { atomicAdd(&(bar)[XB_TMO], 1u); break; } } } } while (0)
struct XcdBarrier { unsigned* bar; unsigned x; volatile LAS unsigned* st; };
DI XcdBarrier xcd_barrier_post(unsigned* bar, volatile LAS unsigned* st) {
    XcdBarrier b; b.bar = bar; b.x = xb_xcc_id(); b.st = st;
    if (threadIdx.x == 0) (void)xb_add(&bar[XB_XCNT(b.x)], 1u);
    return b;
}
DI void xcd_barrier_complete(unsigned* bar, unsigned x, unsigned& nloc, unsigned& nx) {
    const unsigned G = gridDim.x * gridDim.y * gridDim.z;
    unsigned sum, cnt, mine, sp = 0u;
    for (;;) {
        sum = 0u; cnt = 0u; mine = 0u;
#pragma unroll
        for (unsigned j = 0; j < 16; ++j) { const unsigned c = xb_ld(&bar[XB_XCNT(j)]); sum += c; cnt += (c > 0u) ? 1u : 0u; mine = (j == x) ? c : mine; }
        if (sum == G) break;
        __builtin_amdgcn_s_sleep(1);
        if ((++sp & 255u) == 0u) { if (xb_ld(&bar[XB_TMO])) break; if (sp > XB_SPIN_CAP) { atomicAdd(&bar[XB_TMO], 1u); break; } }
    }
    nloc = mine > 0u ? mine : 1u; nx = cnt > 0u ? cnt : 1u;
}
DI void xcd_barrier(const XcdBarrier& b) {
    asm volatile("s_waitcnt vmcnt(0)" ::: "memory");
    __syncthreads();
    if (threadIdx.x == 0) {
        unsigned* bar = b.bar;
        __builtin_amdgcn_s_waitcnt(0);
        unsigned nloc = b.st[0], nx = b.st[1];
        if (nloc == 0u) { xcd_barrier_complete(bar, b.x, nloc, nx); b.st[0] = nloc; b.st[1] = nx; }
        const unsigned old = xb_add(&bar[XB_XSUB(b.x)], 1u);
        const unsigned gen = old / nloc;
        if (old + 1u == (gen + 1u) * nloc) {
            __builtin_amdgcn_fence(__ATOMIC_RELEASE, "agent");
            asm volatile("s_waitcnt vmcnt(0)" ::: "memory");
            const unsigned og = xb_add(&bar[XB_TOP], 1u);
            const unsigned tg = og / nx;
            if (og + 1u == (tg + 1u) * nx) xb_add(&bar[XB_TOPGEN], 1u);
            else XB_SPIN(xb_ld(&bar[XB_TOPGEN]) == tg, bar);
            __builtin_amdgcn_fence(__ATOMIC_ACQUIRE, "agent");
            xb_add(&bar[XB_XGEN(b.x)], 1u);
            asm volatile("s_waitcnt vmcnt(0)" ::: "memory");
        } else {
            XB_SPIN(xb_ld(&bar[XB_XGEN(b.x)]) == gen, bar);
            __builtin_amdgcn_fence(__ATOMIC_ACQUIRE, "agent");
            asm volatile("s_waitcnt vmcnt(0)" ::: "memory");
        }
    }
    __syncthreads();
}

#define REP_PRO 1
#define REP_NORM 1
#define REP_GQKV 1
#define REP_ATTN 1
#define REP_GRQKV 1
#define REP_RIRS 1
#define REP_RI 1
#define REP_GGU 1
#define REP_SYNC 0
#define REPEAT(n) _Pragma("unroll 1") for (int rep_ = 0; rep_ < (n); ++rep_)
#define REPEAT2(n) _Pragma("unroll 1") for (int rep2_ = 0; rep2_ < (n); ++rep2_)
__global__ void __launch_bounds__(512) fwd_megakernel(Params P) {
    extern __shared__ __attribute__((aligned(16))) unsigned char lds_raw[];
    LAS unsigned char* lds = (LAS unsigned char*)lds_raw;
    cg::grid_group grid = cg::this_grid();
    const int G = gridDim.x, bid = blockIdx.x;
    const int wid0 = __builtin_amdgcn_readfirstlane(threadIdx.x >> 6);
    volatile LAS unsigned* bst = (volatile LAS unsigned*)(lds + LDS_BYTES - 16);
    if (threadIdx.x < 4) bst[threadIdx.x] = 0u;
    __syncthreads();
    const XcdBarrier xbar = xcd_barrier_post((unsigned*)(P.ws + WS_CTL), bst);
#define GSYNC() xcd_barrier(xbar)
    unsigned char* ws = P.ws;
#define MOD ((float*)(ws + WS_MOD))
#define ROPEA_C ((float*)(ws + WS_ROPEA))
#define ROPEA_S (ROPEA_C + SEQ * 32)
#define ROPER_C ((float*)(ws + WS_ROPER))
#define ROPER_S (ROPER_C + SEQ * 128)
#define XC ((float*)(ws + WS_XC))
#define SS ((float*)(ws + WS_SS))
#define WQKV ((bf16_t*)(ws + WS_WQKV))
#define WAO ((bf16_t*)(ws + WS_WAO))
#define WP ((bf16_t*)(ws + WS_WP))
#define WIN ((bf16_t*)(ws + WS_WIN))
#define WRO ((bf16_t*)(ws + WS_WRO))
#define WGU ((bf16_t*)(ws + WS_WGU))
#define WD ((bf16_t*)(ws + WS_WD))
#define H ((bf16_t*)(ws + WS_H))
#define QKV ((bf16_t*)(ws + WS_QKV))
#define AO ((bf16_t*)(ws + WS_AO))
#define HID ((bf16_t*)(ws + WS_HID))
#define POOLED ((bf16_t*)(ws + WS_POOLED))
#define RQKV ((bf16_t*)(ws + WS_RQKV))
#define YF ((bf16_t*)(ws + WS_YF))
#define YB ((bf16_t*)(ws + WS_YB))
#define Z ((bf16_t*)(ws + WS_Z))
    REPEAT(REP_PRO) {
        const int tid = opaque_tid(wid0), lane = tid & 63, wid = __builtin_amdgcn_readfirstlane(tid >> 6);
        const int gw = bid * 8 + wid, NGW = G * 8, gtid = bid * 512 + tid, NT = G * 512;
        LAS float* sc = (LAS float*)lds;
        for (int blk = bid; blk < 48; blk += G) {
            __syncthreads();
            for (int i = tid; i < 9 * DM; i += 512) { const int bb = i >> 10, k = i & 1023; const float v = bb < 8 ? P.c[bb * DM + k] : P.c_ctx[k]; sc[i] = silu_f(v); }
            __syncthreads();
            const int idx = blk * 512 + tid, l = idx / MODW, n = idx % MODW;
            const float* w = P.ada_w + (size_t)l * DM * MODW + n;
            float a[9];
#pragma unroll
            for (int bb = 0; bb < 9; ++bb) a[bb] = 0.f;
#pragma unroll 4
            for (int k = 0; k < DM; ++k) {
                const float wv = w[(size_t)k * MODW];
#pragma unroll
                for (int bb = 0; bb < 9; ++bb) a[bb] += sc[bb * DM + k] * wv;
            }
            const float bv = P.ada_b[l * MODW + n];
#pragma unroll
            for (int bb = 0; bb < 9; ++bb) MOD[(l * 9 + bb) * MODW + n] = a[bb] + bv;
        }
        __syncthreads();
        for (int i = gtid; i < SEQ * 32; i += NT) {
            const int t = i >> 5, j = i & 31; const float pos = (float)(j < 16 ? (t >> 6) : (t & 63));
            const float inv = powf(10000.0f, -(float)(j & 15) / 16.0f); const float ang = pos * inv;
            ROPEA_C[i] = cosf(ang); ROPEA_S[i] = sinf(ang);
        }
        for (int i = gtid; i < SEQ * 128; i += NT) {
            const int t = i >> 7, j = i & 127;
            const float inv = powf(10000.0f, -((float)j / 127.0f)); const float ang = (float)t * inv;
            ROPER_C[i] = cosf(ang); ROPER_S[i] = sinf(ang);
        }
        LAS float* scr = (LAS float*)(lds + 40960 + wid * 8704);
        int cnt = 0;
        for (int s = 0; s < 2; ++s) {
            transpose_matrix(P.attn_w_qkv + (size_t)s * DM * 1536, DM, 1536, 0, 1536, WQKV + (size_t)s * 1536 * DM, DM, 0, 1, scr, lane, gw, NGW, cnt);
            transpose_matrix(P.attn_w_o + (size_t)s * DM * DM, DM, DM, 0, DM, WAO + (size_t)s * DM * DM, DM, 0, 0, scr, lane, gw, NGW, cnt);
        }
        for (int g = 0; g < 4; ++g) transpose_matrix(P.pool_w + (size_t)g * 256 * 256, 256, 256, 0, 256, WP, 256, g * 256, 0, scr, lane, gw, NGW, cnt);
        transpose_matrix(P.ret_w_in, DM, 8192, 0, 4096, WIN, DM, 0, 0, scr, lane, gw, NGW, cnt);
        transpose_matrix(P.ret_w_in, DM, 8192, 4096, 2048, WIN, DM, 4096, 2, scr, lane, gw, NGW, cnt);
        transpose_matrix(P.ret_w_in, DM, 8192, 6144, 2048, WIN, DM, 4096, 3, scr, lane, gw, NGW, cnt);
        transpose_matrix(P.ret_w_o, 2048, DM, 0, DM, WRO, 2048, 0, 0, scr, lane, gw, NGW, cnt);
        for (int l = 0; l < 4; ++l) {
            transpose_matrix(P.ffn_w_gate + (size_t)l * DM * FFH, DM, FFH, 0, FFH, WGU + (size_t)l * 5632 * DM, DM, 0, 2, scr, lane, gw, NGW, cnt);
            transpose_matrix(P.ffn_w_up + (size_t)l * DM * FFH, DM, FFH, 0, FFH, WGU + (size_t)l * 5632 * DM, DM, 0, 3, scr, lane, gw, NGW, cnt);
            transpose_matrix(P.ffn_w_down + (size_t)l * FFH * DM, FFH, DM, 0, DM, WD + (size_t)l * DM * FFH, FFH, 0, 0, scr, lane, gw, NGW, cnt);
        }
        grid.sync();
    }

    const float* bl = P.x; const float* bc = P.ctx;
#pragma unroll 1
    for (int layer = 0; layer < 4; ++layer) {
        const int kind = layer % 3, slot = layer / 3;
        const float* modl = MOD + (size_t)layer * 9 * MODW;
        REPEAT(REP_NORM) { prenorm_phase(bl, bc, P.norm_mix + layer * DM, modl, 0, 1, H, G, bid, wid0); GSYNC(); }
        if (kind == 0) {
            REPEAT(REP_GQKV) {
                pg8::Gemm g{H, WQKV + (size_t)slot * 1536 * DM, DM, DM, DM, 0, 0}; pg8::Sched S; S.init(NTILE_M, 6, G, bid, NTILE_M, 0, 0);
                pg8::EpiAttnQKV E{QKV, P.attn_q_norm + slot * 64, P.attn_k_norm + slot * 64, ROPEA_C, ROPEA_S};
                pg8::gemm_phase(lds, g, S, E, wid0);
                GSYNC();
            }
            REPEAT(REP_ATTN) { attn_phase(lds, QKV, AO, P.attn_sink + slot * 16, layer < 3, G, bid, wid0); GSYNC(); }
            {
                pg8::Gemm g{AO, WAO + (size_t)slot * DM * DM, DM, DM, DM, 0, 0}; pg8::Sched S; S.init(NTILE_M, 4, G, bid, NTILE_M, 0, 0);
                pg8::EpiResid E{bl, bc, P.out, XC, modl + 2 * DM, nullptr};
                pg8::gemm_phase(lds, g, S, E, wid0);
            }
        } else if (kind == 1) {
            REPEAT(REP_NORM) { pool_phase(H, POOLED, G, bid, wid0); GSYNC(); }
            {
                pg8::Gemm g{POOLED, WP, DM, 256, 256, 0, 1}; pg8::Sched S; S.init(NTILE_M, 4, G, bid, NTILE_M, 0, 0);
                pg8::EpiResid E{bl, bc, P.out, XC, modl + 2 * DM, P.pool_scale + slot * DM};
                pg8::gemm_phase(lds, g, S, E, wid0);
            }
        } else {
#pragma unroll 1
            for (int hb = 0; hb < 2; ++hb) {
                const int s0b = hb * 128, s1b = 256 + hb * 4;
                REPEAT(REP_GRQKV) {
                    pg8::Gemm g{H, WIN, DM, DM, DM, 0, 0}; pg8::Sched S; S.init(132, 16, G, bid, 128, s0b, s1b);
                    pg8::EpiRetQKV E{RQKV, ROPER_C, ROPER_S};
                    pg8::gemm_phase(lds, g, S, E, wid0);
                    GSYNC();
                }
                REPEAT(REP_RIRS) {
                    REPEAT2(REP_RI) { ret_intra_phase(lds, RQKV, YF, YB, G, bid, wid0); GSYNC(); }
                    ret_scan_phase(lds, RQKV, YF, YB, SS, G, bid, wid0);
                    GSYNC();
                }
                {
                    pg8::Gemm g{H, WIN + (size_t)4096 * DM, DM, DM, DM, 0, 0}; pg8::Sched S; S.init(132, 16, G, bid, 128, s0b, s1b);
                    pg8::EpiRetGate E{YF, YB, SS, Z};
                    pg8::gemm_phase(lds, g, S, E, wid0);
                }
                GSYNC();
                {
                    pg8::Gemm g{Z, WRO, 2048, 2048, 2048, 1, 0}; pg8::Sched S; S.init(132, 4, G, bid, 128, s0b, s1b);
                    pg8::EpiResid E{bl, bc, P.out, XC, modl + 2 * DM, nullptr};
                    pg8::gemm_phase(lds, g, S, E, wid0);
                }
                if (hb == 0) GSYNC();
            }
        }
        GSYNC();
        bl = P.out; bc = XC;
        REPEAT(REP_NORM) { prenorm_phase(bl, bc, P.norm_ffn + layer * DM, modl, 3, 4, H, G, bid, wid0); GSYNC(); }
        REPEAT(REP_GGU) {
            pg8::Gemm g{H, WGU + (size_t)layer * 5632 * DM, DM, DM, DM, 0, 0}; pg8::Sched S; S.init(NTILE_M, 22, G, bid, NTILE_M, 0, 0);
            pg8::EpiSwiGLU E{HID};
            pg8::gemm_phase(lds, g, S, E, wid0);
            GSYNC();
        }
        {
            pg8::Gemm g{HID, WD + (size_t)layer * DM * FFH, FFH, FFH, FFH, 0, 0}; pg8::Sched S; S.init(NTILE_M, 4, G, bid, NTILE_M, 0, 0);
            pg8::EpiResid E{bl, bc, P.out, XC, modl + 5 * DM, nullptr};
            pg8::gemm_phase(lds, g, S, E, wid0);
        }
        GSYNC();
        REPEAT(REP_SYNC) GSYNC();
    }
}

extern "C" void kernel_launch(void* const* d_in, const int* in_sizes, int n_in, void* d_out, int out_size, void* d_ws, size_t ws_size, hipStream_t stream) {
    static int grid_blocks = 0;
    if (grid_blocks == 0) {
        if (n_in != 20 || ws_size < WS_END) { fprintf(stderr, "kernel_launch: unexpected inputs (n_in %d, ws %zu)\n", n_in, ws_size); grid_blocks = -1; return; }
        int dev = 0, cus = 0, per_cu = 0;
        hipGetDevice(&dev);
        hipDeviceGetAttribute(&cus, hipDeviceAttributeMultiprocessorCount, dev);
        if (hipFuncSetAttribute((const void*)fwd_megakernel, hipFuncAttributeMaxDynamicSharedMemorySize, LDS_BYTES) != hipSuccess) { fprintf(stderr, "kernel_launch: hipFuncSetAttribute failed\n"); grid_blocks = -1; return; }
        if (hipOccupancyMaxActiveBlocksPerMultiprocessor(&per_cu, (const void*)fwd_megakernel, 512, LDS_BYTES) != hipSuccess || per_cu < 1) { fprintf(stderr, "kernel_launch: occupancy query failed (%d)\n", per_cu); per_cu = 1; (void)hipGetLastError(); }
        grid_blocks = cus * per_cu;
    }
    if (grid_blocks < 0) return;
    Params p{};
    p.x = (const float*)d_in[0]; p.c = (const float*)d_in[1]; p.ctx = (const float*)d_in[2]; p.c_ctx = (const float*)d_in[3]; p.ada_w = (const float*)d_in[4]; p.ada_b = (const float*)d_in[5];
    p.norm_mix = (const float*)d_in[6]; p.norm_ffn = (const float*)d_in[7]; p.attn_w_qkv = (const float*)d_in[8]; p.attn_w_o = (const float*)d_in[9]; p.attn_q_norm = (const float*)d_in[10];
    p.attn_k_norm = (const float*)d_in[11]; p.attn_sink = (const float*)d_in[12]; p.pool_w = (const float*)d_in[13]; p.pool_scale = (const float*)d_in[14]; p.ret_w_in = (const float*)d_in[15];
    p.ret_w_o = (const float*)d_in[16]; p.ffn_w_gate = (const float*)d_in[17]; p.ffn_w_up = (const float*)d_in[18]; p.ffn_w_down = (const float*)d_in[19];
    p.out = (float*)d_out; p.ws = (unsigned char*)d_ws;
    if (hipMemsetAsync((char*)d_ws + WS_CTL, 0, 16384, stream) != hipSuccess) { fprintf(stderr, "kernel_launch: memset failed\n"); return; }
    void* args[] = {&p};
    hipError_t e = hipLaunchCooperativeKernel((const void*)fwd_megakernel, dim3(grid_blocks), dim3(512), args, LDS_BYTES, stream);
    if (e != hipSuccess) fprintf(stderr, "cooperative launch failed: %s (grid %d)\n", hipGetErrorString(e), grid_blocks);
}
```

```cpp
#include <hip/hip_runtime.h>
#include <hip/hip_cooperative_groups.h>
#include <cstdio>
#include <cstdint>
namespace cg = cooperative_groups;

#define DI __device__ __forceinline__
#define LAS __attribute__((address_space(3)))
typedef unsigned short bf16_t;
typedef short bf16x8 __attribute__((ext_vector_type(8)));
typedef short s16x4 __attribute__((ext_vector_type(4)));
typedef float f32x4 __attribute__((ext_vector_type(4)));
typedef float f32x16 __attribute__((ext_vector_type(16)));
typedef unsigned u32x4 __attribute__((ext_vector_type(4)));
typedef unsigned u32x2 __attribute__((ext_vector_type(2)));
typedef float f32x2_t __attribute__((ext_vector_type(2)));
typedef __bf16 bf16x2_t __attribute__((ext_vector_type(2)));
typedef short v4i16_t __attribute__((ext_vector_type(4)));

DI unsigned pk2(float lo, float hi) { f32x2_t v = {lo, hi}; bf16x2_t b = __builtin_convertvector(v, bf16x2_t); return __builtin_bit_cast(unsigned, b); }
DI float bflo(unsigned w) { return __uint_as_float(w << 16); }
DI float bfhi(unsigned w) { return __uint_as_float(w & 0xffff0000u); }
DI float silu_f(float x) { return x * __builtin_amdgcn_rcpf(1.0f + __expf(-x)); }
DI size_t rfrag(int mat, int rowtile, int s, int r, int hh) { return ((((size_t)mat * 1056 + rowtile) * 16 + s) * 64 + r * 2 + hh) * 8; }
DI int crow(int reg, int h) { return (reg & 3) + 8 * (reg >> 2) + 4 * h; }
DI float shx(float v, int m, int lane) { return __int_as_float(__builtin_amdgcn_ds_bpermute((lane ^ m) << 2, __float_as_int(v))); }
DI float wave_sum(float v, int lane) {
#pragma unroll
    for (int o = 1; o < 64; o <<= 1) v += shx(v, o, lane);
    return v;
}
DI int opaque_tid(int wid0) { int l; asm volatile("v_mbcnt_lo_u32_b32 %0, -1, 0\n\tv_mbcnt_hi_u32_b32 %0, -1, %0" : "=v"(l)); return wid0 * 64 + l; }
DI int opq(int v) { asm volatile("" : "+v"(v)); return v; }
#define LDS_BARRIER() do { asm volatile("s_waitcnt lgkmcnt(0)" ::: "memory"); __builtin_amdgcn_s_barrier(); asm volatile("" ::: "memory"); } while (0)
#define MFMA32(a, b, c) __builtin_amdgcn_mfma_f32_32x32x16_bf16((a), (b), (c), 0, 0, 0)
DI s16x4 trd(const LAS unsigned char* p) { return __builtin_bit_cast(s16x4, __builtin_amdgcn_ds_read_tr16_b64_v4i16((LAS v4i16_t*)p)); }
DI bf16x8 cat8(s16x4 lo, s16x4 hi) { return __builtin_shufflevector(lo, hi, 0, 1, 2, 3, 4, 5, 6, 7); }
DI bf16x8 pack8(const f32x16& x, int s) {
    u32x4 p; p.x = pk2(x[8 * s], x[8 * s + 1]); p.y = pk2(x[8 * s + 2], x[8 * s + 3]); p.z = pk2(x[8 * s + 4], x[8 * s + 5]); p.w = pk2(x[8 * s + 6], x[8 * s + 7]);
    return __builtin_bit_cast(bf16x8, p);
}

constexpr int DM = 1024, NB = 8, SEQ = 8192, CTXL = 256, FFH = 2816;
constexpr int MLAT = NB * SEQ, MCTX = NB * CTXL, MTOT = MLAT + MCTX;
constexpr int NTILE_M = MTOT / 256;
constexpr int MODW = 6 * DM;
constexpr int MHALF = 4 * SEQ + 4 * CTXL;
constexpr float NEPS = 1e-6f;

constexpr size_t MiB = 1u << 20;
constexpr size_t WS_MOD = 0;
constexpr size_t WS_CTL = 896 * 1024;
constexpr size_t WS_ROPEA = 1 * MiB;
constexpr size_t WS_ROPER = 3 * MiB;
constexpr size_t WS_XC = 11 * MiB;
constexpr size_t WS_SS = 19 * MiB;
constexpr size_t WS_ZERO = 35 * MiB + 640 * 1024;
constexpr size_t WS_WQKV = 36 * MiB;
constexpr size_t WS_WAO = 42 * MiB;
constexpr size_t WS_WP = 46 * MiB;
constexpr size_t WS_WIN = 47 * MiB;
constexpr size_t WS_WRO = 63 * MiB;
constexpr size_t WS_WGU = 67 * MiB;
constexpr size_t WS_WD = 111 * MiB;
constexpr size_t WS_H = 133 * MiB;
constexpr size_t WS_BIG = 265 * MiB;
constexpr size_t WS_QKV = WS_BIG;
constexpr size_t WS_AO = WS_BIG + 198 * MiB;
constexpr size_t WS_HID = WS_BIG;
constexpr size_t WS_POOLED = WS_BIG;
constexpr size_t WS_RQKV = WS_BIG;
constexpr size_t WS_YF = WS_BIG + 264 * MiB;
constexpr size_t WS_YB = WS_BIG + 396 * MiB;
constexpr size_t WS_Z = WS_BIG;
constexpr size_t WS_XB = WS_BIG + 528 * MiB;
constexpr size_t WS_END = WS_BIG + 660 * MiB;

constexpr int LDS_BYTES = 147456;

namespace pg8 {
constexpr int STAGGER_TICKS = 35;
constexpr int BM = 256, BK = 64, HALF = 128, HTB = HALF * BK * 2, STAGE_BYTES = 8 * HTB, NXCD = 8, WGM = 8;
DI int lds_byte(int r, int c) { const int st = (r >> 4) * 2 + (c >> 5), rr = r & 15, cc = c & 31, ob = rr * 64 + cc * 2; return st * 1024 + (ob ^ (((ob >> 9) & 1) << 5)); }
DI void stage_rc(int b, int& R, int& C) { const int st = b / 1024, sb = b % 1024, swz = sb ^ (((sb >> 9) & 1) << 5); R = (st >> 1) * 16 + swz / 64; C = (st & 1) * 32 + (swz % 64) / 2; }
DI int perm32(int rho) { const int n = rho >> 4, i = rho & 15; return 8 * (i >> 2) + 4 * n + (i & 3); }

struct Unit { int pm, pn, lt; };
struct Gemm { const bf16_t* A; const bf16_t* Bt; int lda, ldb, K; int a_local; int grouped; };

struct Sched {
    int nM, nN, nwg, G, c, s0n, s0b, s1b;
    DI void init(int nM_, int nN_, int G_, int c_, int s0n_, int s0b_, int s1b_) { nM = nM_; nN = nN_; nwg = nM * nN; G = G_; c = c_; s0n = s0n_; s0b = s0b_; s1b = s1b_; }
    DI bool next(int i, Unit& u) const {
        const long L = (long)i * G + c; if (L >= nwg) return false;
        int wgid = (int)L; { const int q = nwg / NXCD, r = nwg % NXCD, xcd = wgid % NXCD, off = wgid / NXCD; wgid = (xcd < r ? xcd * (q + 1) : r * (q + 1) + (xcd - r) * q) + off; }
        const int nig = WGM * nN, gid = wgid / nig, fm = gid * WGM, gsz = (nM - fm) < WGM ? (nM - fm) : WGM;
        const int t = fm + ((wgid % nig) % gsz); u.pn = (wgid % nig) / gsz; u.lt = t; u.pm = t < s0n ? s0b + t : s1b + (t - s0n); return true;
    }
};

template <class Epi>
DI void gemm_phase(LAS unsigned char* lds, const Gemm g, const Sched& S, const Epi& E, int wid0) {
    const int tid = opaque_tid(wid0), wid = __builtin_amdgcn_readfirstlane(tid >> 6), lane = tid & 63, wr = wid >> 2, wc = wid & 3, fr = lane & 15, fq = lane >> 4;
    const int K = g.K, nt = K / BK;
    unsigned voffA[2], voffB[2];
#pragma unroll
    for (int i = 0; i < 2; ++i) { int R, C; stage_rc(tid * 16 + i * 8192, R, C); const int Rb = Epi::PERM ? ((R & ~31) + perm32(R & 31)) : R;
        voffA[i] = (unsigned)(R * g.lda + C) * 2u; voffB[i] = (unsigned)(Rb * g.ldb + C) * 2u; }
    const size_t kstep = (size_t)(BK * 2);
    const size_t hstepA = (size_t)HALF * g.lda * 2, hstepB = (size_t)HALF * g.ldb * 2;
    const size_t tstepA = 2 * hstepA, tstepB = 2 * hstepB;
    const unsigned ldsw = (unsigned)wid * 1024u;
    const int aoff = lds_byte(wr * 64 + fr, fq * 8), boff = lds_byte(wc * 32 + fr, fq * 8);
#define PG8_SA(b, h) (((b) * 2 + (h)) * HTB)
#define PG8_SB(b, h) ((4 + (b) * 2 + (h)) * HTB)
#define PG8_STAGE(bufoff, gbase, voff) do { _Pragma("unroll") for (int _i = 0; _i < 2; ++_i) \
        __builtin_amdgcn_global_load_lds((const unsigned*)((const char*)(gbase) + (voff)[_i]), (LAS unsigned*)(lds + (bufoff) + ldsw + _i * 8192), 16, 0, 0); } while (0)
#define PG8_LDA(dst, b, h) do { _Pragma("unroll") for (int m = 0; m < 4; ++m) _Pragma("unroll") for (int k = 0; k < 2; ++k) dst[m][k] = *(const LAS bf16x8*)(lds + PG8_SA(b, h) + aoff + m * 2048 + k * 1024); } while (0)
#define PG8_LDB(dst, b, h) do { _Pragma("unroll") for (int n = 0; n < 2; ++n) _Pragma("unroll") for (int k = 0; k < 2; ++k) dst[n][k] = *(const LAS bf16x8*)(lds + PG8_SB(b, h) + boff + n * 2048 + k * 1024); } while (0)
#define PG8_MMA(ai, bj, At, Bt) do { __builtin_amdgcn_s_setprio(1); _Pragma("unroll") for (int m = 0; m < 4; ++m) _Pragma("unroll") for (int n = 0; n < 2; ++n) _Pragma("unroll") for (int k = 0; k < 2; ++k) \
        acc[ai][bj][m][n] = __builtin_amdgcn_mfma_f32_16x16x32_bf16(Bt[n][k], At[m][k], acc[ai][bj][m][n], 0, 0, 0); __builtin_amdgcn_s_setprio(0); } while (0)
#define PG8_WAIT_V(n) asm volatile("s_waitcnt vmcnt(" #n ")" ::: "memory")
#define PG8_WAIT_L(n) asm volatile("s_waitcnt lgkmcnt(" #n ")" ::: "memory")
#define PG8_BAR __builtin_amdgcn_s_barrier()
#define PG8_SCHED __builtin_amdgcn_sched_barrier(0)
#define PG8_APTR(u) ((const char*)g.A + (size_t)(g.a_local ? (u).lt : (u).pm) * tstepA + (g.grouped ? (size_t)(u).pn * K * 2 : (size_t)0))
#define PG8_BPTR(u) ((const char*)g.Bt + (size_t)(u).pn * tstepB)
    Unit cur, nxt; int ui = 0;
    if (!S.next(0, cur)) return;
    if (Epi::STAGGER) {
        const int nmine = (S.nwg - S.c + S.G - 1) / S.G, nmax = (S.nwg + S.G - 1) / S.G;
        if (nmine < nmax) {
            const unsigned long long delay = (unsigned long long)(((S.c >> 3) & 3) * nt * STAGGER_TICKS);
            const unsigned long long t0 = __builtin_amdgcn_s_memrealtime();
            while (__builtin_amdgcn_s_memrealtime() - t0 < delay) __builtin_amdgcn_s_sleep(32);
        }
    }
    f32x4 acc[2][2][4][2];
#pragma unroll
    for (int a = 0; a < 2; ++a)
#pragma unroll
        for (int b = 0; b < 2; ++b)
#pragma unroll
            for (int m = 0; m < 4; ++m)
#pragma unroll
                for (int n = 0; n < 2; ++n) acc[a][b][m][n] = (f32x4){0.f, 0.f, 0.f, 0.f};
    bf16x8 At[4][2], B0[2][2], B1[2][2];
    const char* cA = PG8_APTR(cur); const char* cB = PG8_BPTR(cur);
    PG8_STAGE(PG8_SB(0, 0), cB, voffB); PG8_STAGE(PG8_SB(0, 1), cB + hstepB, voffB); PG8_STAGE(PG8_SA(0, 0), cA, voffA); PG8_STAGE(PG8_SA(0, 1), cA + hstepA, voffA);
    if (wr == 1) PG8_BAR;
    PG8_WAIT_V(2); PG8_BAR;
    PG8_STAGE(PG8_SB(1, 0), cB + kstep, voffB); PG8_STAGE(PG8_SA(1, 0), cA + kstep, voffA); PG8_STAGE(PG8_SB(1, 1), cB + hstepB + kstep, voffB);
    PG8_WAIT_V(6); PG8_BAR;
    for (;;) {
        const bool has_next = S.next(ui + 1, nxt);
        const char* nA = has_next ? PG8_APTR(nxt) : cA; const char* nB = has_next ? PG8_BPTR(nxt) : cB;
        for (int t = 0; t < nt; t += 2) {
            const bool last = (t == nt - 2);
            const char* a1 = cA + (size_t)(t + 1) * kstep;
            const char* a2 = last ? nA : cA + (size_t)(t + 2) * kstep; const char* b2 = last ? nB : cB + (size_t)(t + 2) * kstep;
            const char* a3 = a2 + kstep; const char* b3 = b2 + kstep;
            PG8_LDB(B0, 0, 0); PG8_LDB(B1, 0, 1); PG8_SCHED; PG8_LDA(At, 0, 0); PG8_STAGE(PG8_SA(1, 1), a1 + hstepA, voffA);
            PG8_WAIT_V(8); PG8_WAIT_L(0); PG8_BAR; PG8_MMA(0, 0, At, B0); PG8_MMA(0, 1, At, B1); PG8_BAR; PG8_SCHED;
            PG8_LDA(At, 0, 1); PG8_STAGE(PG8_SB(0, 0), b2, voffB); PG8_STAGE(PG8_SB(0, 1), b2 + hstepB, voffB); PG8_STAGE(PG8_SA(0, 0), a2, voffA);
            PG8_WAIT_V(8); PG8_WAIT_L(0); PG8_BAR; PG8_MMA(1, 0, At, B0); PG8_MMA(1, 1, At, B1); PG8_BAR; PG8_SCHED;
            PG8_LDB(B0, 1, 0); PG8_LDB(B1, 1, 1); PG8_SCHED; PG8_LDA(At, 1, 0); PG8_STAGE(PG8_SA(0, 1), a2 + hstepA, voffA);
            PG8_WAIT_V(8); PG8_WAIT_L(0); PG8_BAR; PG8_MMA(0, 0, At, B0); PG8_MMA(0, 1, At, B1); PG8_BAR; PG8_SCHED;
            PG8_LDA(At, 1, 1); PG8_STAGE(PG8_SB(1, 0), b3, voffB); PG8_STAGE(PG8_SB(1, 1), b3 + hstepB, voffB); PG8_STAGE(PG8_SA(1, 0), a3, voffA);
            PG8_WAIT_V(8); PG8_WAIT_L(0); PG8_BAR; PG8_MMA(1, 0, At, B0); PG8_MMA(1, 1, At, B1); PG8_BAR; PG8_SCHED;
        }
        if (wr == 0) PG8_BAR;
        E(acc, cur, wr, wc, fr, fq);
        if (!has_next) break;
#pragma unroll
        for (int a = 0; a < 2; ++a)
#pragma unroll
            for (int b = 0; b < 2; ++b)
#pragma unroll
                for (int m = 0; m < 4; ++m)
#pragma unroll
                    for (int n = 0; n < 2; ++n) acc[a][b][m][n] = (f32x4){0.f, 0.f, 0.f, 0.f};
        cur = nxt; cA = nA; cB = nB; ++ui;
        if (wr == 1) PG8_BAR;
    }
    PG8_WAIT_V(0);
    PG8_BAR;
#undef PG8_SA
#undef PG8_SB
#undef PG8_STAGE
#undef PG8_LDA
#undef PG8_LDB
#undef PG8_MMA
#undef PG8_WAIT_V
#undef PG8_WAIT_L
#undef PG8_BAR
#undef PG8_SCHED
#undef PG8_APTR
#undef PG8_BPTR
}

typedef f32x4 Acc[2][2][4][2];

template <bool BF32, bool OF32>
struct EpiResid {
    static constexpr bool PERM = false, STAGGER = false;
    const float* base_l; const float* base_c; bf16_t* XBp; float* outf; const float* gate; const float* colscale;
    DI void operator()(const Acc& acc, const Unit& u, int wr, int wc, int fr, int fq) const {
        const bool lat = u.pm < 256; const int bb = lat ? (u.pm >> 5) : 8;
        const size_t rowt = lat ? (size_t)u.pm * 256 : (size_t)(u.pm - 256) * 256;
        const float* bp = (lat ? base_l : base_c) + rowt * DM;
        bf16_t* xp = XBp + (size_t)u.pm * 256 * DM; float* op = outf + (size_t)u.pm * 256 * DM;
        const float* gp = gate + bb * MODW;
        const int col0 = u.pn * 256 + wc * 32 + 4 * fq;
        f32x4 gv[2][2];
#pragma unroll
        for (int bj = 0; bj < 2; ++bj)
#pragma unroll
            for (int n = 0; n < 2; ++n) {
                const int c = col0 + bj * 128 + n * 16;
                gv[bj][n] = *(const f32x4*)(gp + c);
                if (colscale) gv[bj][n] = gv[bj][n] * *(const f32x4*)(colscale + c);
            }
        constexpr int PD = 3;
        f32x4 buf[PD + 1][4]; u32x2 bufh[PD + 1][4];
#define ER_LOAD(g_) do { const int bj_ = (g_) >> 2, n_ = ((g_) >> 1) & 1, ai_ = (g_) & 1; const int c_ = col0 + bj_ * 128 + n_ * 16; const int frx_ = opq(fr); \
            _Pragma("unroll") for (int m_ = 0; m_ < 4; ++m_) { const size_t o_ = (size_t)(ai_ * 128 + wr * 64 + m_ * 16 + frx_) * DM + c_; \
                if (BF32) buf[(g_) & PD][m_] = *(const f32x4*)(bp + o_); else bufh[(g_) & PD][m_] = *(const u32x2*)(xp + o_); } } while (0)
#pragma unroll
        for (int g = 0; g < PD; ++g) ER_LOAD(g);
#pragma unroll
        for (int g = 0; g < 8; ++g) {
            const int bj = g >> 2, n = (g >> 1) & 1, ai = g & 1;
            const int c = col0 + bj * 128 + n * 16;
            if (g + PD < 8) ER_LOAD(g + PD);
            asm volatile("" ::: "memory");
            {
                const int frx = opq(fr);
#pragma unroll
                for (int m = 0; m < 4; ++m) {
                    const size_t o_ = (size_t)(ai * 128 + wr * 64 + m * 16 + frx) * DM + c;
                    f32x4 bv;
                    if (BF32) bv = buf[g & PD][m]; else { const u32x2 hw = bufh[g & PD][m]; bv = (f32x4){bflo(hw.x), bfhi(hw.x), bflo(hw.y), bfhi(hw.y)}; }
                    const f32x4 o = bv + acc[ai][bj][m][n] * gv[bj][n];
                    if (OF32) *(f32x4*)(op + o_) = o; else { u32x2 w; w.x = pk2(o[0], o[1]); w.y = pk2(o[2], o[3]); *(u32x2*)(xp + o_) = w; }
                }
            }
            asm volatile("" ::: "memory");
        }
#undef ER_LOAD
    }
};

struct EpiSwiGLU {
    static constexpr bool PERM = true, STAGGER = false;
    bf16_t* HID;
    DI void operator()(const Acc& acc, const Unit& u, int wr, int wc, int fr, int fq) const {
        const int hc0 = u.pn * 128 + wc * 32 + 8 * fq;
#pragma unroll
        for (int ai = 0; ai < 2; ++ai)
#pragma unroll
            for (int m = 0; m < 4; ++m) {
                const f32x4 g0 = acc[ai][0][m][0], g1 = acc[ai][0][m][1], u0 = acc[ai][1][m][0], u1 = acc[ai][1][m][1];
                const size_t row0 = (size_t)u.pm * 256 + wr * 64 + opq(fr);
                u32x4 w;
                w.x = pk2(silu_f(g0[0]) * u0[0], silu_f(g0[1]) * u0[1]); w.y = pk2(silu_f(g0[2]) * u0[2], silu_f(g0[3]) * u0[3]);
                w.z = pk2(silu_f(g1[0]) * u1[0], silu_f(g1[1]) * u1[1]); w.w = pk2(silu_f(g1[2]) * u1[2], silu_f(g1[3]) * u1[3]);
                *(u32x4*)(HID + (row0 + ai * 128 + m * 16) * FFH + hc0) = w;
                asm volatile("" ::: "memory");
            }
    }
};

struct EpiAttnQKV {
    static constexpr bool PERM = true, STAGGER = false;
    bf16_t* QKV; const float* qg; const float* kg; const float* cosT; const float* sinT;
    DI void operator()(const Acc& acc, const Unit& u, int wr, int wc, int fr, int fq) const {
        const int mode = u.pn < 4 ? 0 : (u.pn == 4 ? 1 : 2);
        const bool lat = u.pm < 256; const int tok0 = (u.pm * 256) & (SEQ - 1);
        const int jb = 8 * fq;
        const float* gp = mode == 0 ? qg : kg;
        f32x4 gn[2][2];
#pragma unroll
        for (int bj = 0; bj < 2; ++bj)
#pragma unroll
            for (int n = 0; n < 2; ++n) gn[bj][n] = *(const f32x4*)(gp + 32 * bj + jb + 4 * n);
        const int outcol = (mode == 0 ? u.pn * 256 : (mode == 1 ? 1024 : 1280)) + wc * 64 + jb;
        const bool rot = mode < 2 && lat;
        f32x4 cb[3][2], sb[3][2];
#define AQ_LOADCS(i_) do { const int t_ = tok0 + ((i_) >> 2) * 128 + wr * 64 + ((i_) & 3) * 16 + opq(fr); \
            _Pragma("unroll") for (int n_ = 0; n_ < 2; ++n_) { cb[(i_) % 2][n_] = *(const f32x4*)(cosT + t_ * 32 + jb + 4 * n_); sb[(i_) % 2][n_] = *(const f32x4*)(sinT + t_ * 32 + jb + 4 * n_); } } while (0)
        if (rot) { AQ_LOADCS(0); }
#pragma unroll
        for (int ai = 0; ai < 2; ++ai)
#pragma unroll
            for (int m = 0; m < 4; ++m) {
                const int rl = ai * 128 + wr * 64 + m * 16 + opq(fr);
                f32x4 csc[2], snc[2];
#pragma unroll
                for (int n = 0; n < 2; ++n) { csc[n] = cb[(ai * 4 + m) % 2][n]; snc[n] = sb[(ai * 4 + m) % 2][n]; }
                if (rot && ai * 4 + m + 1 < 8) AQ_LOADCS(ai * 4 + m + 1);
                f32x4 v[2][2];
#pragma unroll
                for (int bj = 0; bj < 2; ++bj)
#pragma unroll
                    for (int n = 0; n < 2; ++n) v[bj][n] = acc[ai][bj][m][n];
                if (mode < 2) {
                    float ss = 0.f;
#pragma unroll
                    for (int bj = 0; bj < 2; ++bj)
#pragma unroll
                        for (int n = 0; n < 2; ++n) { const f32x4 x = v[bj][n]; ss += (x[0] * x[0] + x[1] * x[1]) + (x[2] * x[2] + x[3] * x[3]); }
                    { const int ln = fr + 16 * fq; ss += shx(ss, 16, ln); ss += shx(ss, 32, ln); }
                    float rs = rsqrtf(ss * (1.0f / 64.0f) + NEPS); if (mode == 0) rs *= 0.125f * 1.4426950408889634f;
#pragma unroll
                    for (int bj = 0; bj < 2; ++bj)
#pragma unroll
                        for (int n = 0; n < 2; ++n) v[bj][n] = v[bj][n] * rs * gn[bj][n];
                    if (lat) {
#pragma unroll
                        for (int n = 0; n < 2; ++n) {
                            const f32x4 cs = csc[n], sn = snc[n];
                            const f32x4 x1 = v[0][n], x2 = v[1][n];
                            v[0][n] = x1 * cs - x2 * sn; v[1][n] = x2 * cs + x1 * sn;
                        }
                    }
                }
                bf16_t* rp = QKV + ((size_t)u.pm * 256 + rl) * 1536 + outcol;
#pragma unroll
                for (int bj = 0; bj < 2; ++bj) {
                    u32x4 w; w.x = pk2(v[bj][0][0], v[bj][0][1]); w.y = pk2(v[bj][0][2], v[bj][0][3]); w.z = pk2(v[bj][1][0], v[bj][1][1]); w.w = pk2(v[bj][1][2], v[bj][1][3]);
                    *(u32x4*)(rp + 32 * bj) = w;
                }
                asm volatile("" ::: "memory");
            }
#undef AQ_LOADCS
    }
};

struct EpiRetQKV {
    static constexpr bool PERM = true, STAGGER = false;
    bf16_t* RQp; bf16_t* RVp; const float* cosT; const float* sinT; float* SSp;
    DI void operator()(const Acc& acc, const Unit& u, int wr, int wc, int fr, int fq) const {
        const bool lat = u.pm < 256; const int tok0 = (u.pm * 256) & (SEQ - 1);
        const int j0 = 32 * wc + 8 * fq;
        const float sc = (u.pn >= 4 && u.pn < 8) ? 0.0625f : 1.0f;
        if (u.pn == 0) { float zf = 0.f; asm volatile("" : "+v"(zf)); *(f32x4*)(SSp + (size_t)u.lt * 256 * 8 + ((wr * 4 + wc) * 64 + fq * 16 + fr) * 4) = (f32x4){zf, zf, zf, zf}; }
        const bool rot = u.pn < 8 && lat;
        f32x4 cb[3][2], sb[3][2];
#define RQ_LOADCS(i_) do { const int t_ = tok0 + ((i_) >> 2) * 128 + wr * 64 + ((i_) & 3) * 16 + opq(fr); \
            _Pragma("unroll") for (int n_ = 0; n_ < 2; ++n_) { cb[(i_) % 3][n_] = *(const f32x4*)(cosT + t_ * 128 + j0 + 4 * n_); sb[(i_) % 3][n_] = *(const f32x4*)(sinT + t_ * 128 + j0 + 4 * n_); } } while (0)
        if (rot) { RQ_LOADCS(0); RQ_LOADCS(1); }
#pragma unroll
        for (int ai = 0; ai < 2; ++ai)
#pragma unroll
            for (int m = 0; m < 4; ++m) {
                const int rl = ai * 128 + wr * 64 + m * 16 + opq(fr);
                if (rot && ai * 4 + m + 2 < 8) RQ_LOADCS(ai * 4 + m + 2);
                f32x4 v[2][2];
#pragma unroll
                for (int bj = 0; bj < 2; ++bj)
#pragma unroll
                    for (int n = 0; n < 2; ++n) v[bj][n] = acc[ai][bj][m][n] * sc;
                if (u.pn < 8 && lat) {
#pragma unroll
                    for (int n = 0; n < 2; ++n) {
                        const f32x4 cs = cb[(ai * 4 + m) % 3][n], sn = sb[(ai * 4 + m) % 3][n];
                        const f32x4 x1 = v[0][n], x2 = v[1][n];
                        v[0][n] = x1 * cs - x2 * sn; v[1][n] = x2 * cs + x1 * sn;
                    }
                }
                const int lrow = u.lt * 256 + rl;
#pragma unroll
                for (int bj = 0; bj < 2; ++bj) {
                    u32x4 w; w.x = pk2(v[bj][0][0], v[bj][0][1]); w.y = pk2(v[bj][0][2], v[bj][0][3]); w.z = pk2(v[bj][1][0], v[bj][1][1]); w.w = pk2(v[bj][1][2], v[bj][1][3]);
                    bf16_t* rp = u.pn < 8 ? RQp + rfrag(u.pn, lrow >> 5, 8 * bj + 2 * wc + (fq >> 1), lrow & 31, fq & 1)
                                          : RVp + (size_t)lrow * 2048 + (u.pn - 8) * 256 + 128 * bj + j0;
                    *(u32x4*)rp = w;
                }
                asm volatile("" ::: "memory");
            }
#undef RQ_LOADCS
    }
};

struct EpiRetGate {
    static constexpr bool PERM = true, STAGGER = false;
    const bf16_t* YF; const bf16_t* YB; const float* SS; bf16_t* Z;
    DI void operator()(const Acc& acc, const Unit& u, int wr, int wc, int fr, int fq) const {
        const int c0 = u.pn * 128 + 32 * wc + 8 * fq, head = u.pn >> 2;
        u32x4 yfb[3], ybb[3]; f32x2_t ssb[3];
#define RG_LOAD(i_) do { const size_t lr_ = (size_t)u.lt * 256 + ((i_) >> 2) * 128 + wr * 64 + ((i_) & 3) * 16 + opq(fr); \
            ssb[(i_) % 3] = *(const f32x2_t*)(SS + (lr_ * 4 + head) * 2); yfb[(i_) % 3] = *(const u32x4*)(YF + lr_ * 2048 + c0); ybb[(i_) % 3] = *(const u32x4*)(YB + lr_ * 2048 + c0); } while (0)
        RG_LOAD(0); RG_LOAD(1);
#pragma unroll
        for (int ai = 0; ai < 2; ++ai)
#pragma unroll
            for (int m = 0; m < 4; ++m) {
                const size_t lrow = (size_t)u.lt * 256 + ai * 128 + wr * 64 + m * 16 + opq(fr);
                if (ai * 4 + m + 2 < 8) RG_LOAD(ai * 4 + m + 2);
                const f32x2_t sq = ssb[(ai * 4 + m) % 3];
                const float rf = rsqrtf(sq.x * (1.0f / 512.0f) + NEPS), rb = rsqrtf(sq.y * (1.0f / 512.0f) + NEPS);
                const u32x4 yf = yfb[(ai * 4 + m) % 3], yb = ybb[(ai * 4 + m) % 3];
                const f32x4 f0 = acc[ai][0][m][0], f1 = acc[ai][0][m][1], b0 = acc[ai][1][m][0], b1 = acc[ai][1][m][1];
                u32x4 w;
                w.x = pk2(silu_f(f0[0]) * bflo(yf.x) * rf + silu_f(b0[0]) * bflo(yb.x) * rb, silu_f(f0[1]) * bfhi(yf.x) * rf + silu_f(b0[1]) * bfhi(yb.x) * rb);
                w.y = pk2(silu_f(f0[2]) * bflo(yf.y) * rf + silu_f(b0[2]) * bflo(yb.y) * rb, silu_f(f0[3]) * bfhi(yf.y) * rf + silu_f(b0[3]) * bfhi(yb.y) * rb);
                w.z = pk2(silu_f(f1[0]) * bflo(yf.z) * rf + silu_f(b1[0]) * bflo(yb.z) * rb, silu_f(f1[1]) * bfhi(yf.z) * rf + silu_f(b1[1]) * bfhi(yb.z) * rb);
                w.w = pk2(silu_f(f1[2]) * bflo(yf.w) * rf + silu_f(b1[2]) * bflo(yb.w) * rb, silu_f(f1[3]) * bfhi(yf.w) * rf + silu_f(b1[3]) * bfhi(yb.w) * rb);
                *(u32x4*)(Z + lrow * 2048 + c0) = w;
                asm volatile("" ::: "memory");
            }
#undef RG_LOAD
    }
};
}

struct Params {
    const float* x; const float* c; const float* ctx; const float* c_ctx; const float* ada_w; const float* ada_b; const float* norm_mix; const float* norm_ffn;
    const float* attn_w_qkv; const float* attn_w_o; const float* attn_q_norm; const float* attn_k_norm; const float* attn_sink;
    const float* pool_w; const float* pool_scale; const float* ret_w_in; const float* ret_w_o; const float* ffn_w_gate; const float* ffn_w_up; const float* ffn_w_down;
    float* out; unsigned char* ws;
};

DI void transpose_item(const float* W, int ldw, int k0, int col0, bf16_t* dst, int ldd, int drow0, LAS float* scr, int lane) {
#pragma unroll 8
    for (int i = 0; i < 32; ++i) { const int kk = 2 * i + (lane >> 5); scr[kk * 33 + (lane & 31)] = W[(size_t)(k0 + kk) * ldw + col0 + (lane & 31)]; }
    asm volatile("s_waitcnt lgkmcnt(0)" ::: "memory");
    const int c = lane & 7;
#pragma unroll
    for (int j = 0; j < 4; ++j) { const int n = (lane >> 3) + 8 * j; const LAS float* s = scr + (8 * c) * 33 + n;
        u32x4 o; o.x = pk2(s[0 * 33], s[1 * 33]); o.y = pk2(s[2 * 33], s[3 * 33]); o.z = pk2(s[4 * 33], s[5 * 33]); o.w = pk2(s[6 * 33], s[7 * 33]);
        *(u32x4*)(dst + (size_t)(drow0 + n) * ldd + k0 + 8 * c) = o; }
    asm volatile("s_waitcnt lgkmcnt(0)" ::: "memory");
}
DI int dst_row_of(int kind, int n0) {
    if (kind == 0) return n0;
    if (kind == 1) return (n0 & ~255) + 128 * ((n0 >> 5) & 1) + 32 * ((n0 >> 6) & 3);
    return 256 * (n0 >> 7) + (n0 & 127) + (kind == 3 ? 128 : 0);
}
DI void transpose_matrix(const float* W, int K, int ldw, int col_off, int ncols, bf16_t* dst, int ldd, int drow_off, int kind, LAS float* scr, int lane, int gw, int NGW, int& cnt) {
    const int nblk = ncols / 32, nitems = (K / 64) * nblk;
    int first = (gw - (cnt % NGW) + NGW) % NGW;
    for (int it = first; it < nitems; it += NGW) {
        const int kb = it / nblk, nb = it % nblk;
        transpose_item(W, ldw, 64 * kb, col_off + 32 * nb, dst, ldd, drow_off + dst_row_of(kind, 32 * nb), scr, lane);
    }
    cnt += nitems;
}

template <bool SRCF32>
DI void prenorm_phase(const float* xl, const float* xc, const bf16_t* XBp, const float* gain, const float* modl, int shi, int sci, bf16_t* H, int rbeg, int mrows, int G, int bid, int wid0) {
    const int tid = opaque_tid(wid0), lane = tid & 63, gw = bid * 8 + __builtin_amdgcn_readfirstlane(tid >> 6), NGW = G * 8;
    constexpr int RW = 4;
    for (int row0 = rbeg + gw * RW; row0 < mrows; row0 += NGW * RW) {
        const bool lat = row0 < MLAT; const int bb = lat ? (row0 >> 13) : 8;
        const float* mp = modl + bb * MODW;
        float s[RW]; float zf = 0.f; asm volatile("" : "+v"(zf)); float epsv = NEPS; asm volatile("" : "+v"(epsv));
        if (SRCF32) {
            const float* src = lat ? xl + (size_t)row0 * DM : xc + (size_t)(row0 - MLAT) * DM;
            f32x4 v[RW][4];
#pragma unroll
            for (int q = 0; q < RW; ++q) {
                s[q] = zf;
#pragma unroll
                for (int j = 0; j < 4; ++j) v[q][j] = *(const f32x4*)(src + (size_t)q * DM + 256 * j + 4 * lane);
            }
#pragma unroll
            for (int q = 0; q < RW; ++q)
#pragma unroll
                for (int j = 0; j < 4; ++j) s[q] += (v[q][j][0] * v[q][j][0] + v[q][j][1] * v[q][j][1]) + (v[q][j][2] * v[q][j][2] + v[q][j][3] * v[q][j][3]);
#pragma unroll
            for (int o = 1; o < 64; o <<= 1)
#pragma unroll
                for (int q = 0; q < RW; ++q) s[q] += shx(s[q], o, lane);
#pragma unroll
            for (int j = 0; j < 4; ++j) {
                const int col = 256 * j + 4 * lane;
                const f32x4 g = *(const f32x4*)(gain + col), sc = *(const f32x4*)(mp + sci * DM + col), sh = *(const f32x4*)(mp + shi * DM + col);
                const f32x4 gs = g * (sc + 1.0f);
#pragma unroll
                for (int q = 0; q < RW; ++q) {
                    const float rstd = rsqrtf(s[q] * (1.0f / DM) + epsv);
                    const f32x4 o = v[q][j] * rstd * gs + sh;
                    u32x2 w; w.x = pk2(o[0], o[1]); w.y = pk2(o[2], o[3]);
                    *(u32x2*)(H + (size_t)(row0 + q) * DM + col) = w;
                }
            }
        } else {
            const bf16_t* src = XBp + (size_t)row0 * DM;
            u32x4 v[RW][2];
#pragma unroll
            for (int q = 0; q < RW; ++q) {
                s[q] = zf;
#pragma unroll
                for (int j = 0; j < 2; ++j) v[q][j] = *(const u32x4*)(src + (size_t)q * DM + 512 * j + 8 * lane);
            }
#pragma unroll
            for (int q = 0; q < RW; ++q)
#pragma unroll
                for (int j = 0; j < 2; ++j) {
                    const u32x4 w = v[q][j];
                    const float a0 = bflo(w.x), a1 = bfhi(w.x), a2 = bflo(w.y), a3 = bfhi(w.y), a4 = bflo(w.z), a5 = bfhi(w.z), a6 = bflo(w.w), a7 = bfhi(w.w);
                    s[q] += ((a0 * a0 + a1 * a1) + (a2 * a2 + a3 * a3)) + ((a4 * a4 + a5 * a5) + (a6 * a6 + a7 * a7));
                }
#pragma unroll
            for (int o = 1; o < 64; o <<= 1)
#pragma unroll
                for (int q = 0; q < RW; ++q) s[q] += shx(s[q], o, lane);
#pragma unroll
            for (int j = 0; j < 2; ++j) {
                const int col = 512 * j + 8 * lane;
                f32x4 gs[2], sh[2];
#pragma unroll
                for (int t = 0; t < 2; ++t) { gs[t] = *(const f32x4*)(gain + col + 4 * t) * (*(const f32x4*)(mp + sci * DM + col + 4 * t) + 1.0f); sh[t] = *(const f32x4*)(mp + shi * DM + col + 4 * t); }
#pragma unroll
                for (int q = 0; q < RW; ++q) {
                    const float rstd = rsqrtf(s[q] * (1.0f / DM) + epsv);
                    const u32x4 w = v[q][j];
                    const f32x4 x0 = (f32x4){bflo(w.x), bfhi(w.x), bflo(w.y), bfhi(w.y)}, x1 = (f32x4){bflo(w.z), bfhi(w.z), bflo(w.w), bfhi(w.w)};
                    const f32x4 o0 = x0 * rstd * gs[0] + sh[0], o1 = x1 * rstd * gs[1] + sh[1];
                    u32x4 ow; ow.x = pk2(o0[0], o0[1]); ow.y = pk2(o0[2], o0[3]); ow.z = pk2(o1[0], o1[1]); ow.w = pk2(o1[2], o1[3]);
                    *(u32x4*)(H + (size_t)(row0 + q) * DM + col) = ow;
                }
            }
        }
    }
}
template <int HW>
DI void pool_item(const bf16_t* Hn, bf16_t* Pq, int row, int c8) {
    int t, T, rbase;
    if (row < MLAT) { t = row & (SEQ - 1); T = SEQ; rbase = row - t; } else { t = (row - MLAT) & (CTXL - 1); T = CTXL; rbase = row - t; }
    u32x4 w[2 * HW];
#pragma unroll
    for (int k = 0; k < 2 * HW; ++k) { int tt = t - HW + k; tt = tt < 0 ? 0 : (tt > T - 1 ? T - 1 : tt); w[k] = *(const u32x4*)(Hn + (size_t)(rbase + tt) * DM + c8); }
    float a[8]; float cnt = 0.f;
#pragma unroll
    for (int e = 0; e < 8; ++e) a[e] = 0.f;
#pragma unroll
    for (int k = 0; k < 2 * HW; ++k) {
        const int tt = t - HW + k; const float m = (tt >= 0 && tt < T) ? 1.0f : 0.0f; cnt += m;
        a[0] += bflo(w[k].x) * m; a[1] += bfhi(w[k].x) * m; a[2] += bflo(w[k].y) * m; a[3] += bfhi(w[k].y) * m; a[4] += bflo(w[k].z) * m; a[5] += bfhi(w[k].z) * m; a[6] += bflo(w[k].w) * m; a[7] += bfhi(w[k].w) * m;
    }
    const float inv = 1.0f / cnt; const u32x4 c = w[HW];
    u32x4 o;
    o.x = pk2(a[0] * inv - bflo(c.x), a[1] * inv - bfhi(c.x)); o.y = pk2(a[2] * inv - bflo(c.y), a[3] * inv - bfhi(c.y));
    o.z = pk2(a[4] * inv - bflo(c.z), a[5] * inv - bfhi(c.z)); o.w = pk2(a[6] * inv - bflo(c.w), a[7] * inv - bfhi(c.w));
    *(u32x4*)(Pq + (size_t)row * DM + c8) = o;
}
DI void pool_phase(const bf16_t* H, bf16_t* P, int G, int bid, int wid0) {
    const int tid = opaque_tid(wid0), lane = tid & 63, gw = bid * 8 + __builtin_amdgcn_readfirstlane(tid >> 6), NGW = G * 8;
    for (int wi = gw; wi < (MTOT / 2) * 4; wi += NGW) {
        const int rp = wi >> 2, grp = wi & 3, row = 2 * rp + (lane >> 5), c8 = grp * 256 + (lane & 31) * 8;
        if (grp == 0) pool_item<1>(H, P, row, c8); else if (grp == 1) pool_item<2>(H, P, row, c8); else if (grp == 2) pool_item<4>(H, P, row, c8); else pool_item<8>(H, P, row, c8);
    }
}

constexpr int AT_KOFF = 0, AT_VOFF = 128 * 144, AT_PITCH = 144, AT_VPITCH = 192;
DI void attn_phase(LAS unsigned char* lds, const bf16_t* QKV, bf16_t* AO, const float* sink, bool do_ctx, int G, int bid, int wid0) {
    const int tid = opaque_tid(wid0), lane = tid & 63, wid = __builtin_amdgcn_readfirstlane(tid >> 6);
    const int r = lane & 31, hh = lane >> 5, i16 = lane & 15, q4 = i16 >> 2, p4 = i16 & 3, blk = (lane >> 4) & 1;
    const int nunits = 2048 + (do_ctx ? 64 : 0);
    const int vcu = (G % 8 == 0) ? (bid % 8) * (G / 8) + bid / 8 : bid;
    for (int u = vcu; u < nunits; u += G) {
        int b, kvh, qb; bool isctx;
        if (u < 2048) { b = u >> 8; kvh = (u >> 6) & 3; qb = u & 63; isctx = false; } else { const int v = u - 2048; b = v >> 3; kvh = (v >> 1) & 3; qb = v & 1; isctx = true; }
        const size_t qrow0 = isctx ? (size_t)(MLAT + b * CTXL + qb * 128) : (size_t)(b * SEQ + qb * 128);
        const int g = wid >> 1, qh = wid & 1, head = kvh * 4 + g;
        bf16x8 qf[2][4];
#pragma unroll
        for (int qt = 0; qt < 2; ++qt)
#pragma unroll
            for (int s = 0; s < 4; ++s) qf[qt][s] = *(const bf16x8*)(QKV + (qrow0 + qh * 64 + qt * 32 + r) * 1536 + head * 64 + 16 * s + 8 * hh);
        f32x16 o[2][2]; float l[2] = {0.f, 0.f};
#pragma unroll
        for (int a = 0; a < 2; ++a)
#pragma unroll
            for (int c = 0; c < 2; ++c)
#pragma unroll
                for (int e = 0; e < 16; ++e) o[a][c][e] = 0.f;
#define AT_VALID(c_) ((c_) >= 3 || (!isctx && (qb - 1 + (c_)) >= 0 && (qb - 1 + (c_)) <= 63))
#define AT_KROW(c_) ((c_) < 3 ? (size_t)(b * SEQ + (qb - 1 + (c_)) * 128) : (size_t)(MLAT + b * CTXL + ((c_) - 3) * 128))
#define AT_LOAD(c_) do { const size_t kr_ = AT_KROW(c_); _Pragma("unroll") for (int i_ = 0; i_ < 2; ++i_) { const int p_ = tid + 512 * i_, row_ = p_ >> 3, ch_ = p_ & 7; \
            kreg[i_] = *(const u32x4*)(QKV + (kr_ + row_) * 1536 + 1024 + kvh * 64 + ch_ * 8); vreg[i_] = *(const u32x4*)(QKV + (kr_ + row_) * 1536 + 1280 + kvh * 64 + ch_ * 8); } } while (0)
        u32x4 kreg[2], vreg[2];
        int c = 0; while (!AT_VALID(c)) ++c;
        AT_LOAD(c);
        while (c < 5) {
            LDS_BARRIER();
#pragma unroll
            for (int i = 0; i < 2; ++i) {
                const int p = tid + 512 * i, row = p >> 3, ch = p & 7;
                *(LAS u32x4*)(lds + AT_KOFF + row * AT_PITCH + ch * 16) = kreg[i];
                *(LAS u32x4*)(lds + AT_VOFF + row * AT_VPITCH + ch * 16) = vreg[i];
            }
            int cn = c + 1; while (cn < 5 && !AT_VALID(cn)) ++cn;
            if (cn < 5) AT_LOAD(cn);
            LDS_BARRIER();
            const int relbase = (c - 1) * 128;
#pragma unroll 1
            for (int kb32 = 0; kb32 < 4; ++kb32) {
                bf16x8 kf[4];
#pragma unroll
                for (int s = 0; s < 4; ++s) kf[s] = *(const LAS bf16x8*)(lds + AT_KOFF + (kb32 * 32 + r) * AT_PITCH + (16 * s + 8 * hh) * 2);
                bf16x8 vf[2][2];
#pragma unroll
                for (int dt = 0; dt < 2; ++dt)
#pragma unroll
                    for (int s2 = 0; s2 < 2; ++s2) {
                        const LAS unsigned char* vp = lds + AT_VOFF + (kb32 * 32 + 16 * s2 + 4 * hh + q4) * AT_VPITCH + (dt * 32 + 16 * blk) * 2 + 8 * p4;
                        vf[dt][s2] = cat8(trd(vp), trd(vp + 8 * AT_VPITCH));
                    }
#pragma unroll
                for (int qt = 0; qt < 2; ++qt) {
                    const int qlo = qh * 64 + qt * 32;
                    if (c == 0 && kb32 * 32 + 31 < qlo) continue;
                    if (c == 2 && kb32 * 32 > qlo + 31) continue;
                    f32x16 sa;
#pragma unroll
                    for (int e = 0; e < 16; ++e) sa[e] = 0.f;
#pragma unroll
                    for (int s = 0; s < 4; ++s) sa = MFMA32(kf[s], qf[qt][s], sa);
                    const int qi = qlo + r;
                    float ls = 0.f;
                    if (c == 0 || c == 2) {
#pragma unroll
                        for (int e = 0; e < 16; ++e) {
                            float p = __builtin_amdgcn_exp2f(sa[e]);
                            const int rel = relbase + kb32 * 32 + crow(e, hh) - qi; if (rel > 128 || rel < -128) p = 0.f;
                            sa[e] = p; ls += p;
                        }
                    } else {
#pragma unroll
                        for (int e = 0; e < 16; ++e) { const float p = __builtin_amdgcn_exp2f(sa[e]); sa[e] = p; ls += p; }
                    }
                    l[qt] += ls;
                    const bf16x8 p0 = pack8(sa, 0), p1 = pack8(sa, 1);
#pragma unroll
                    for (int dt = 0; dt < 2; ++dt) { o[dt][qt] = MFMA32(vf[dt][0], p0, o[dt][qt]); o[dt][qt] = MFMA32(vf[dt][1], p1, o[dt][qt]); }
                }
            }
            c = cn;
        }
#undef AT_VALID
#undef AT_KROW
#undef AT_LOAD
        const float es = __expf(sink[head]);
#pragma unroll
        for (int qt = 0; qt < 2; ++qt) {
            const float lt = l[qt] + shx(l[qt], 32, lane) + es;
            const float inv = 1.0f / lt;
            bf16_t* op = AO + (qrow0 + qh * 64 + qt * 32 + r) * DM + head * 64;
#pragma unroll
            for (int dt = 0; dt < 2; ++dt)
#pragma unroll
                for (int g4 = 0; g4 < 4; ++g4) {
                    u32x2 w; w.x = pk2(o[dt][qt][4 * g4] * inv, o[dt][qt][4 * g4 + 1] * inv); w.y = pk2(o[dt][qt][4 * g4 + 2] * inv, o[dt][qt][4 * g4 + 3] * inv);
                    *(u32x2*)(op + dt * 32 + 8 * g4 + 4 * hh) = w;
                }
        }
    }
}

DI float ret_log2g(int h, int dir) { return log2f(1.0f - exp2f(-5.0f - (dir ? 0.5f : 0.0f) - (float)h)); }
constexpr int RI_PITCH = 1040;
DI void ret_intra_phase(LAS unsigned char* lds, const bf16_t* RQp, const bf16_t* RVp, bf16_t* YF, bf16_t* YB, int G, int bid, int wid0) {
    const int tid = opaque_tid(wid0), lane = tid & 63, wid = __builtin_amdgcn_readfirstlane(tid >> 6);
    const int r = lane & 31, hh = lane >> 5, i16 = lane & 15, q4 = i16 >> 2, p4 = i16 & 3, blk = (lane >> 4) & 1;
    const int it = wid & 3, dir = wid >> 2;
    for (int u = bid; u < 1056; u += G) {
        const int b4 = u / 264, rem = u % 264, h = rem / 66, ch = rem % 66;
        const size_t lrow0 = ch < 64 ? (size_t)(b4 * SEQ + ch * 128) : (size_t)(4 * SEQ + b4 * CTXL + (ch - 64) * 128);
        __syncthreads();
#pragma unroll 4
        for (int i = 0; i < 16; ++i) {
            const int p = tid + 512 * i, row = p >> 6, cn = p & 63;
            *(LAS u32x4*)(lds + row * RI_PITCH + cn * 16) = *(const u32x4*)(RVp + (lrow0 + row) * 2048 + h * 512 + cn * 8);
        }
        const bf16_t* qp = RQp + rfrag(h, (int)(lrow0 >> 5) + it, 0, r, hh);
        const float l2g = ret_log2g(h, dir);
        bf16x8 pf[4][2];
#pragma unroll
        for (int jt = 0; jt < 4; ++jt) {
            const bool need = dir == 0 ? (jt <= it) : (jt >= it);
            if (need) {
                f32x16 sa;
#pragma unroll
                for (int e = 0; e < 16; ++e) sa[e] = 0.f;
                const bf16_t* kp = RQp + rfrag(4 + h, (int)(lrow0 >> 5) + jt, 0, r, hh);
#pragma unroll 8
                for (int s = 0; s < 16; ++s) {
                    const bf16x8 kf = *(const bf16x8*)(kp + 512 * s);
                    sa = MFMA32(kf, *(const bf16x8*)(qp + 512 * s), sa);
                }
                const int i = it * 32 + r;
#pragma unroll
                for (int e = 0; e < 16; ++e) {
                    const int j = jt * 32 + crow(e, hh); const int diff = dir == 0 ? i - j : j - i;
                    sa[e] = diff >= 0 ? sa[e] * exp2f((float)diff * l2g) : 0.f;
                }
                pf[jt][0] = pack8(sa, 0); pf[jt][1] = pack8(sa, 1);
            } else { pf[jt][0] = (bf16x8){0, 0, 0, 0, 0, 0, 0, 0}; pf[jt][1] = pf[jt][0]; }
        }
        __syncthreads();
        bf16_t* Y = (dir ? YB : YF) + (lrow0 + it * 32 + r) * 2048 + h * 512;
#pragma unroll 1
        for (int vt = 0; vt < 16; ++vt) {
            f32x16 acc;
#pragma unroll
            for (int e = 0; e < 16; ++e) acc[e] = 0.f;
#pragma unroll
            for (int jt = 0; jt < 4; ++jt) {
                const bool need = dir == 0 ? (jt <= it) : (jt >= it);
                if (need) {
#pragma unroll
                    for (int s2 = 0; s2 < 2; ++s2) {
                        const LAS unsigned char* vp = lds + (jt * 32 + 16 * s2 + 4 * hh + q4) * RI_PITCH + (vt * 32 + 16 * blk) * 2 + 8 * p4;
                        acc = MFMA32(cat8(trd(vp), trd(vp + 8 * RI_PITCH)), pf[jt][s2], acc);
                    }
                }
            }
#pragma unroll
            for (int g4 = 0; g4 < 4; ++g4) {
                u32x2 w; w.x = pk2(acc[4 * g4], acc[4 * g4 + 1]); w.y = pk2(acc[4 * g4 + 2], acc[4 * g4 + 3]);
                *(u32x2*)(Y + vt * 32 + 8 * g4 + 4 * hh) = w;
            }
        }
    }
}

#define XB_TMO      128
#define XB_XCNT(j)  (256  + 64 * (j))
#define XB_XSUB(j)  (1280 + 64 * (j))
#define XB_XGEN(j)  (2304 + 64 * (j))
#define XB_TOP      3328
#define XB_TOPGEN   3392
#define XCD_BAR_WORDS 3456
#define XB_SPIN_CAP (1u << 18)
DI unsigned xb_ld(unsigned* p)              { return __hip_atomic_load(p, __ATOMIC_RELAXED, __HIP_MEMORY_SCOPE_AGENT); }
DI unsigned xb_add(unsigned* p, unsigned v) { return __hip_atomic_fetch_add(p, v, __ATOMIC_RELAXED, __HIP_MEMORY_SCOPE_AGENT); }
DI unsigned xb_xcc_id() { return (unsigned)__builtin_amdgcn_s_getreg((3 << 11) | 20) & 0xFu; }
#define XB_SPIN(cond, bar) do { unsigned _sp = 0; while (cond) { __builtin_amdgcn_s_sleep(1); \
    if ((++_sp & 255u) == 0u) { if (xb_ld(&(bar)[XB_TMO])) break; if (_sp > XB_SPIN_CAP) { atomicAdd(&(bar)[XB_TMO], 1u); break; } } } } while (0)
struct XcdBarrier { unsigned* bar; unsigned x; volatile LAS unsigned* st; };
DI XcdBarrier xcd_barrier_post(unsigned* bar, volatile LAS unsigned* st) {
    XcdBarrier b; b.bar = bar; b.x = xb_xcc_id(); b.st = st;
    if (threadIdx.x == 0) (void)xb_add(&bar[XB_XCNT(b.x)], 1u);
    return b;
}
DI void xcd_barrier_complete(unsigned* bar, unsigned x, unsigned& nloc, unsigned& nx) {
    const unsigned G = gridDim.x * gridDim.y * gridDim.z;
    unsigned sum, cnt, mine, sp = 0u;
    for (;;) {
        sum = 0u; cnt = 0u; mine = 0u;
#pragma unroll
        for (unsigned j = 0; j < 16; ++j) { const unsigned c = xb_ld(&bar[XB_XCNT(j)]); sum += c; cnt += (c > 0u) ? 1u : 0u; mine = (j == x) ? c : mine; }
        if (sum == G) break;
        __builtin_amdgcn_s_sleep(1);
        if ((++sp & 255u) == 0u) { if (xb_ld(&bar[XB_TMO])) break; if (sp > XB_SPIN_CAP) { atomicAdd(&bar[XB_TMO], 1u); break; } }
    }
    nloc = mine > 0u ? mine : 1u; nx = cnt > 0u ? cnt : 1u;
}
DI void xcd_barrier(const XcdBarrier& b) {
    asm volatile("s_waitcnt vmcnt(0)" ::: "memory");
    __syncthreads();
    if (threadIdx.x == 0) {
        unsigned* bar = b.bar;
        __builtin_amdgcn_s_waitcnt(0);
        unsigned nloc = b.st[0], nx = b.st[1];
        if (nloc == 0u) { xcd_barrier_complete(bar, b.x, nloc, nx); b.st[0] = nloc; b.st[1] = nx; }
        const unsigned old = xb_add(&bar[XB_XSUB(b.x)], 1u);
        const unsigned gen = old / nloc;
        if (old + 1u == (gen + 1u) * nloc) {
            __builtin_amdgcn_fence(__ATOMIC_RELEASE, "agent");
            asm volatile("s_waitcnt vmcnt(0)" ::: "memory");
            const unsigned og = xb_add(&bar[XB_TOP], 1u);
            const unsigned tg = og / nx;
            if (og + 1u == (tg + 1u) * nx) xb_add(&bar[XB_TOPGEN], 1u);
            else XB_SPIN(xb_ld(&bar[XB_TOPGEN]) == tg, bar);
            __builtin_amdgcn_fence(__ATOMIC_ACQUIRE, "agent");
            xb_add(&bar[XB_XGEN(b.x)], 1u);
            asm volatile("s_waitcnt vmcnt(0)" ::: "memory");
        } else {
            XB_SPIN(xb_ld(&bar[XB_XGEN(b.x)]) == gen, bar);
            __builtin_amdgcn_fence(__ATOMIC_ACQUIRE, "agent");
            asm volatile("s_waitcnt vmcnt(0)" ::: "memory");
        }
    }
    __syncthreads();
}

constexpr int RS_KS = 0, RS_KP = 528, RS_VS = 128 * 528, RS_VP = 192, RS_ST = RS_VS + 128 * 192, RS_SP = 528;
DI size_t rs_row0(int step, int dir, int b4) {
    const int ch = dir == 0 ? (step < 2 ? 64 + step : step - 2) : 65 - step;
    return ch < 64 ? (size_t)(b4 * SEQ + ch * 128) : (size_t)(4 * SEQ + b4 * CTXL + (ch - 64) * 128);
}
DI void ret_scan_phase(LAS unsigned char* lds, const bf16_t* RQp, const bf16_t* RVp, bf16_t* YF, bf16_t* YB, float* SS, unsigned* ctl, int cid, int G, int bid, int wid0) {
    const int tid = opaque_tid(wid0), lane = tid & 63, wid = __builtin_amdgcn_readfirstlane(tid >> 6);
    const int r = lane & 31, hh = lane >> 5, i16 = lane & 15, q4 = i16 >> 2, p4 = i16 & 3, blk = (lane >> 4) & 1;
    const int c16 = lane & 15, rq = lane >> 4;
    for (int item0 = bid; item0 < 256; item0 += G) {
        int item = item0;
        if (G == 256) {
            volatile LAS unsigned* bw = (volatile LAS unsigned*)(lds + LDS_BYTES - 16);
            __syncthreads();
            if (tid == 0) {
                bool dyn = true;
#pragma unroll
                for (int j = 0; j < 16; ++j) { const unsigned c = xb_ld(&ctl[XB_XCNT(j)]); dyn = dyn && (c == (j < 8 ? 32u : 0u)); }
                unsigned it;
                if (dyn) { const unsigned x = xb_xcc_id(); const unsigned idx = xb_add(&ctl[4096 + (cid * 16 + x) * 64], 1u); it = (x < 8u && idx < 32u) ? x * 32u + idx : 0xffffffffu; }
                else { const int xcd = item0 & 7, idx = item0 >> 3; it = (unsigned)(((xcd * 4 + (idx >> 3)) << 3) | (idx & 7)); }
                bw[2] = it;
            }
            __syncthreads();
            item = (int)bw[2];
            if (item < 0) item = item0;
        }
        const int sl = item & 7, dir = (item >> 3) & 1, h = (item >> 4) & 3, b4 = item >> 6;
        bf16_t* Y = dir ? YB : YF;
        const float l2g = ret_log2g(h, dir);
        f32x16 S[2];
#pragma unroll
        for (int e = 0; e < 16; ++e) { S[0][e] = 0.f; S[1][e] = 0.f; }
        __syncthreads();
        for (int i = tid; i < 64 * RS_SP / 4; i += 512) *(LAS unsigned*)(lds + RS_ST + 4 * i) = 0u;
        const float cdec = exp2f(l2g * 128.0f);
        const int vrow = tid >> 3, vc16 = tid & 7;
        const int kldso = RS_KS + ((tid >> 1) & 31) * RS_KP + (16 * ((tid >> 6) & 7) + 8 * (tid & 1)) * 2;
        const int itok = 16 * wid + c16;
        const float qd = exp2f(l2g * (float)(dir ? 128 - itok : itok + 1));
        const float fi = exp2f(l2g * (float)(dir ? -itok : itok - 127));
        u32x4 kreg[8], vreg[2]; bf16x8 qn[8];
#define RS_LOAD(step_) do { const size_t l_ = rs_row0((step_), dir, b4); \
            _Pragma("unroll") for (int i_ = 0; i_ < 8; ++i_) kreg[i_] = *(const u32x4*)(RQp + rfrag(4 + h, (int)(l_ >> 5), 0, 0, 0) + (size_t)(tid + 512 * i_) * 8); \
            _Pragma("unroll") for (int i_ = 0; i_ < 2; ++i_) vreg[i_] = *(const u32x4*)(RVp + (l_ + vrow + 64 * i_) * 2048 + h * 512 + sl * 64 + vc16 * 8); \
            { const bf16_t* qp_ = RQp + rfrag(h, (int)(l_ >> 5) + (wid >> 1), rq >> 1, 16 * (wid & 1) + c16, rq & 1); \
              _Pragma("unroll") for (int s_ = 0; s_ < 8; ++s_) qn[s_] = *(const bf16x8*)(qp_ + 1024 * s_); } } while (0)
        RS_LOAD(0);
#pragma unroll 1
        for (int step = 0; step < 66; ++step) {
            const size_t lrow0 = rs_row0(step, dir, b4);
#pragma unroll
            for (int i = 0; i < 8; ++i) *(LAS u32x4*)(lds + kldso + (i >> 1) * 32 * RS_KP + (i & 1) * 256) = kreg[i];
#pragma unroll
            for (int i = 0; i < 2; ++i) {
                const int row = vrow + 64 * i; const u32x4 w = vreg[i];
                const float kd = exp2f(l2g * (float)(dir ? row : 127 - row));
                u32x4 o; o.x = pk2(bflo(w.x) * kd, bfhi(w.x) * kd); o.y = pk2(bflo(w.y) * kd, bfhi(w.y) * kd); o.z = pk2(bflo(w.z) * kd, bfhi(w.z) * kd); o.w = pk2(bflo(w.w) * kd, bfhi(w.w) * kd);
                *(LAS u32x4*)(lds + RS_VS + row * RS_VP + vc16 * 16) = o;
            }
            bf16x8 qf[8];
#pragma unroll
            for (int s = 0; s < 8; ++s) qf[s] = qn[s];
            if (step + 1 < 66) RS_LOAD(step + 1);
            LDS_BARRIER();
            if (wid < 4) {
            {
#pragma unroll
                for (int e = 0; e < 16; ++e) { S[0][e] *= cdec; S[1][e] *= cdec; }
#pragma unroll
                for (int s = 0; s < 8; ++s) {
                    const LAS unsigned char* kp = lds + RS_KS + (16 * s + 8 * hh + q4) * RS_KP + (wid * 32 + 16 * blk) * 2 + 8 * p4;
                    const bf16x8 ka = cat8(trd(kp), trd(kp + 4 * RS_KP));
#pragma unroll
                    for (int vt = 0; vt < 2; ++vt) {
                        const LAS unsigned char* vp = lds + RS_VS + (16 * s + 8 * hh + q4) * RS_VP + (vt * 32 + 16 * blk) * 2 + 8 * p4;
                        S[vt] = MFMA32(ka, cat8(trd(vp), trd(vp + 4 * RS_VP)), S[vt]);
                    }
                }
            }
            {
                f32x4 acc[4];
#pragma unroll
                for (int t = 0; t < 4; ++t) acc[t] = (f32x4){0.f, 0.f, 0.f, 0.f};
                const LAS unsigned char* sp = lds + RS_ST + c16 * RS_SP + 16 * rq;
#pragma unroll
                for (int s = 0; s < 8; ++s)
#pragma unroll
                    for (int t = 0; t < 4; ++t) acc[t] = __builtin_amdgcn_mfma_f32_16x16x32_bf16(*(const LAS bf16x8*)(sp + t * 16 * RS_SP + 64 * s), qf[s], acc[t], 0, 0, 0);
#pragma unroll
                for (int t = 0; t < 4; ++t) acc[t] = acc[t] * qd;
#pragma unroll
                for (int p = 0; p < 4; ++p) {
                    const bool need = dir == 0 ? (2 * p <= wid) : (2 * p + 1 >= wid);
                    if (need) {
                        f32x4 sc0 = (f32x4){0.f, 0.f, 0.f, 0.f}, sc1 = (f32x4){0.f, 0.f, 0.f, 0.f};
                        const LAS unsigned char* kq0 = lds + RS_KS + (32 * p + c16) * RS_KP + 16 * rq;
#pragma unroll
                        for (int s = 0; s < 8; ++s) {
                            sc0 = __builtin_amdgcn_mfma_f32_16x16x32_bf16(*(const LAS bf16x8*)(kq0 + 64 * s), qf[s], sc0, 0, 0, 0);
                            sc1 = __builtin_amdgcn_mfma_f32_16x16x32_bf16(*(const LAS bf16x8*)(kq0 + 16 * RS_KP + 64 * s), qf[s], sc1, 0, 0, 0);
                        }
                        float v0[4], v1[4];
#pragma unroll
                        for (int e = 0; e < 4; ++e) {
                            const int j0 = 32 * p + 4 * rq + e, j1 = j0 + 16;
                            const bool k0 = dir == 0 ? (j0 <= itok) : (j0 >= itok), k1 = dir == 0 ? (j1 <= itok) : (j1 >= itok);
                            v0[e] = k0 ? sc0[e] * fi : 0.f; v1[e] = k1 ? sc1[e] * fi : 0.f;
                        }
                        u32x4 pw; pw.x = pk2(v0[0], v0[1]); pw.y = pk2(v0[2], v0[3]); pw.z = pk2(v1[0], v1[1]); pw.w = pk2(v1[2], v1[3]);
                        const bf16x8 pb = __builtin_bit_cast(bf16x8, pw);
#pragma unroll
                        for (int t = 0; t < 4; ++t) {
                            const LAS unsigned char* vp = lds + RS_VS + (32 * p + 4 * rq + (c16 >> 2)) * RS_VP + (16 * t) * 2 + 8 * (c16 & 3);
                            acc[t] = __builtin_amdgcn_mfma_f32_16x16x32_bf16(cat8(trd(vp), trd(vp + 16 * RS_VP)), pb, acc[t], 0, 0, 0);
                        }
                    }
                }
                bf16_t* yp = Y + (lrow0 + itok) * 2048 + h * 512 + sl * 64 + 4 * rq;
                float ssq = 0.f;
#pragma unroll
                for (int t = 0; t < 4; ++t) {
                    const float y0 = acc[t][0], y1 = acc[t][1], y2 = acc[t][2], y3 = acc[t][3];
                    ssq += (y0 * y0 + y1 * y1) + (y2 * y2 + y3 * y3);
                    u32x2 w; w.x = pk2(y0, y1); w.y = pk2(y2, y3);
                    *(u32x2*)(yp + 16 * t) = w;
                }
                ssq += shx(ssq, 16, lane); ssq += shx(ssq, 32, lane);
                if (rq == 0) unsafeAtomicAdd(SS + ((lrow0 + itok) * 4 + h) * 2 + dir, ssq);
            }
            } else {
            {
                f32x4 acc[4];
#pragma unroll
                for (int t = 0; t < 4; ++t) acc[t] = (f32x4){0.f, 0.f, 0.f, 0.f};
                const LAS unsigned char* sp = lds + RS_ST + c16 * RS_SP + 16 * rq;
#pragma unroll
                for (int s = 0; s < 8; ++s)
#pragma unroll
                    for (int t = 0; t < 4; ++t) acc[t] = __builtin_amdgcn_mfma_f32_16x16x32_bf16(*(const LAS bf16x8*)(sp + t * 16 * RS_SP + 64 * s), qf[s], acc[t], 0, 0, 0);
#pragma unroll
                for (int t = 0; t < 4; ++t) acc[t] = acc[t] * qd;
#pragma unroll
                for (int p = 0; p < 4; ++p) {
                    const bool need = dir == 0 ? (2 * p <= wid) : (2 * p + 1 >= wid);
                    if (need) {
                        f32x4 sc0 = (f32x4){0.f, 0.f, 0.f, 0.f}, sc1 = (f32x4){0.f, 0.f, 0.f, 0.f};
                        const LAS unsigned char* kq0 = lds + RS_KS + (32 * p + c16) * RS_KP + 16 * rq;
#pragma unroll
                        for (int s = 0; s < 8; ++s) {
                            sc0 = __builtin_amdgcn_mfma_f32_16x16x32_bf16(*(const LAS bf16x8*)(kq0 + 64 * s), qf[s], sc0, 0, 0, 0);
                            sc1 = __builtin_amdgcn_mfma_f32_16x16x32_bf16(*(const LAS bf16x8*)(kq0 + 16 * RS_KP + 64 * s), qf[s], sc1, 0, 0, 0);
                        }
                        float v0[4], v1[4];
#pragma unroll
                        for (int e = 0; e < 4; ++e) {
                            const int j0 = 32 * p + 4 * rq + e, j1 = j0 + 16;
                            const bool k0 = dir == 0 ? (j0 <= itok) : (j0 >= itok), k1 = dir == 0 ? (j1 <= itok) : (j1 >= itok);
                            v0[e] = k0 ? sc0[e] * fi : 0.f; v1[e] = k1 ? sc1[e] * fi : 0.f;
                        }
                        u32x4 pw; pw.x = pk2(v0[0], v0[1]); pw.y = pk2(v0[2], v0[3]); pw.z = pk2(v1[0], v1[1]); pw.w = pk2(v1[2], v1[3]);
                        const bf16x8 pb = __builtin_bit_cast(bf16x8, pw);
#pragma unroll
                        for (int t = 0; t < 4; ++t) {
                            const LAS unsigned char* vp = lds + RS_VS + (32 * p + 4 * rq + (c16 >> 2)) * RS_VP + (16 * t) * 2 + 8 * (c16 & 3);
                            acc[t] = __builtin_amdgcn_mfma_f32_16x16x32_bf16(cat8(trd(vp), trd(vp + 16 * RS_VP)), pb, acc[t], 0, 0, 0);
                        }
                    }
                }
                bf16_t* yp = Y + (lrow0 + itok) * 2048 + h * 512 + sl * 64 + 4 * rq;
                float ssq = 0.f;
#pragma unroll
                for (int t = 0; t < 4; ++t) {
                    const float y0 = acc[t][0], y1 = acc[t][1], y2 = acc[t][2], y3 = acc[t][3];
                    ssq += (y0 * y0 + y1 * y1) + (y2 * y2 + y3 * y3);
                    u32x2 w; w.x = pk2(y0, y1); w.y = pk2(y2, y3);
                    *(u32x2*)(yp + 16 * t) = w;
                }
                ssq += shx(ssq, 16, lane); ssq += shx(ssq, 32, lane);
                if (rq == 0) unsafeAtomicAdd(SS + ((lrow0 + itok) * 4 + h) * 2 + dir, ssq);
            }
            {
#pragma unroll
                for (int e = 0; e < 16; ++e) { S[0][e] *= cdec; S[1][e] *= cdec; }
#pragma unroll
                for (int s = 0; s < 8; ++s) {
                    const LAS unsigned char* kp = lds + RS_KS + (16 * s + 8 * hh + q4) * RS_KP + (wid * 32 + 16 * blk) * 2 + 8 * p4;
                    const bf16x8 ka = cat8(trd(kp), trd(kp + 4 * RS_KP));
#pragma unroll
                    for (int vt = 0; vt < 2; ++vt) {
                        const LAS unsigned char* vp = lds + RS_VS + (16 * s + 8 * hh + q4) * RS_VP + (vt * 32 + 16 * blk) * 2 + 8 * p4;
                        S[vt] = MFMA32(ka, cat8(trd(vp), trd(vp + 4 * RS_VP)), S[vt]);
                    }
                }
            }
            }
            LDS_BARRIER();
#pragma unroll
            for (int vt = 0; vt < 2; ++vt)
#pragma unroll
                for (int g4 = 0; g4 < 4; ++g4) {
                    u32x2 w; w.x = pk2(S[vt][4 * g4], S[vt][4 * g4 + 1]); w.y = pk2(S[vt][4 * g4 + 2], S[vt][4 * g4 + 3]);
                    *(LAS u32x2*)(lds + RS_ST + (vt * 32 + r) * RS_SP + (wid * 32 + 8 * g4 + 4 * hh) * 2) = w;
                }
        }
#undef RS_LOAD
    }
}

#define REP_PRO 1
#define REP_NORM 1
#define REP_GQKV 1
#define REP_ATTN 1
#define REP_GRQKV 1
#define REP_RIRS 1
#define REP_RI 1
#define REP_GGU 1
#define REP_SYNC 0
#define REP_GDOWN 0
#define REP_GWO 0
#define REP_GGATE 1
#define REP_GRWO 0
#define REPEAT(n) _Pragma("unroll 1") for (int rep_ = 0; rep_ < (n); ++rep_)
#define REPEAT2(n) _Pragma("unroll 1") for (int rep2_ = 0; rep2_ < (n); ++rep2_)
__global__ void __launch_bounds__(512) fwd_megakernel(Params P) {
    extern __shared__ __attribute__((aligned(16))) unsigned char lds_raw[];
    LAS unsigned char* lds = (LAS unsigned char*)lds_raw;
    cg::grid_group grid = cg::this_grid();
    const int G = gridDim.x, bid = blockIdx.x;
    const int wid0 = __builtin_amdgcn_readfirstlane(threadIdx.x >> 6);
    volatile LAS unsigned* bst = (volatile LAS unsigned*)(lds + LDS_BYTES - 16);
    if (threadIdx.x < 4) bst[threadIdx.x] = 0u;
    __syncthreads();
    const XcdBarrier xbar = xcd_barrier_post((unsigned*)(P.ws + WS_CTL), bst);
#define GSYNC() xcd_barrier(xbar)
    unsigned char* ws = P.ws;
#define MOD ((float*)(ws + WS_MOD))
#define ROPEA_C ((float*)(ws + WS_ROPEA))
#define ROPEA_S (ROPEA_C + SEQ * 32)
#define ROPER_C ((float*)(ws + WS_ROPER))
#define ROPER_S (ROPER_C + SEQ * 128)
#define XB ((bf16_t*)(ws + WS_XB))
#define SS ((float*)(ws + WS_SS))
#define WQKV ((bf16_t*)(ws + WS_WQKV))
#define WAO ((bf16_t*)(ws + WS_WAO))
#define WP ((bf16_t*)(ws + WS_WP))
#define WIN ((bf16_t*)(ws + WS_WIN))
#define WRO ((bf16_t*)(ws + WS_WRO))
#define WGU ((bf16_t*)(ws + WS_WGU))
#define WD ((bf16_t*)(ws + WS_WD))
#define H ((bf16_t*)(ws + WS_H))
#define QKV ((bf16_t*)(ws + WS_QKV))
#define AO ((bf16_t*)(ws + WS_AO))
#define HID ((bf16_t*)(ws + WS_HID))
#define POOLED ((bf16_t*)(ws + WS_POOLED))
#define RQ ((bf16_t*)(ws + WS_RQKV))
#define RV ((bf16_t*)(ws + WS_RQKV + 132 * MiB))
#define YF ((bf16_t*)(ws + WS_YF))
#define YB ((bf16_t*)(ws + WS_YB))
#define Z ((bf16_t*)(ws + WS_Z))
    REPEAT(REP_PRO) {
        const int tid = opaque_tid(wid0), lane = tid & 63, wid = __builtin_amdgcn_readfirstlane(tid >> 6);
        const int gw = bid * 8 + wid, NGW = G * 8, gtid = bid * 512 + tid, NT = G * 512;
        LAS float* sc = (LAS float*)lds;
        LAS float* part = (LAS float*)(lds + 36864);
        for (int blk = bid; blk < 192; blk += G) {
            __syncthreads();
            for (int i = tid; i < 9 * DM; i += 512) { const int bb = i >> 10, k = i & 1023; const float v = bb < 8 ? P.c[bb * DM + k] : P.c_ctx[k]; sc[i] = silu_f(v); }
            __syncthreads();
            const int col = tid & 127, kq = tid >> 7;
            const int idx = blk * 128 + col, l = idx / MODW, n = idx % MODW;
            const float* w = P.ada_w + (size_t)l * DM * MODW + n + (size_t)(kq * 256) * MODW;
            float a[9];
#pragma unroll
            for (int bb = 0; bb < 9; ++bb) a[bb] = 0.f;
#pragma unroll 2
            for (int k = 0; k < 256; k += 4) {
                float wv[4];
#pragma unroll
                for (int j = 0; j < 4; ++j) wv[j] = w[(size_t)(k + j) * MODW];
#pragma unroll
                for (int bb = 0; bb < 9; ++bb) { const f32x4 sv = *(const LAS f32x4*)(sc + bb * DM + kq * 256 + k); a[bb] += (sv[0] * wv[0] + sv[1] * wv[1]) + (sv[2] * wv[2] + sv[3] * wv[3]); }
            }
#pragma unroll
            for (int bb = 0; bb < 9; ++bb) part[(kq * 9 + bb) * 128 + col] = a[bb];
            __syncthreads();
            if (kq == 0) {
                const float bv = P.ada_b[l * MODW + n];
#pragma unroll
                for (int bb = 0; bb < 9; ++bb) MOD[(l * 9 + bb) * MODW + n] = ((part[bb * 128 + col] + part[(9 + bb) * 128 + col]) + (part[(18 + bb) * 128 + col] + part[(27 + bb) * 128 + col])) + bv;
            }
        }
        __syncthreads();
        if (REP_GDOWN + REP_GWO + REP_GRWO > 0) for (int i = gtid; i < 9 * MODW; i += NT) ((float*)(ws + WS_ZERO))[i] = 0.f;
        for (int i = gtid; i < SEQ * 32; i += NT) {
            const int t = i >> 5, j = i & 31; const float pos = (float)(j < 16 ? (t >> 6) : (t & 63));
            const float inv = powf(10000.0f, -(float)(j & 15) / 16.0f); const float ang = pos * inv;
            ROPEA_C[i] = cosf(ang); ROPEA_S[i] = sinf(ang);
        }
        for (int i = gtid; i < SEQ * 128; i += NT) {
            const int t = i >> 7, j = i & 127;
            const float inv = powf(10000.0f, -((float)j / 127.0f)); const float ang = (float)t * inv;
            ROPER_C[i] = cosf(ang); ROPER_S[i] = sinf(ang);
        }
        LAS float* scr = (LAS float*)(lds + 57344 + wid * 8704);
        int cnt = 0;
        for (int s = 0; s < 2; ++s) {
            transpose_matrix(P.attn_w_qkv + (size_t)s * DM * 1536, DM, 1536, 0, 1536, WQKV + (size_t)s * 1536 * DM, DM, 0, 1, scr, lane, gw, NGW, cnt);
            transpose_matrix(P.attn_w_o + (size_t)s * DM * DM, DM, DM, 0, DM, WAO + (size_t)s * DM * DM, DM, 0, 0, scr, lane, gw, NGW, cnt);
        }
        for (int g = 0; g < 4; ++g) transpose_matrix(P.pool_w + (size_t)g * 256 * 256, 256, 256, 0, 256, WP, 256, g * 256, 0, scr, lane, gw, NGW, cnt);
        transpose_matrix(P.ret_w_in, DM, 8192, 0, 4096, WIN, DM, 0, 0, scr, lane, gw, NGW, cnt);
        transpose_matrix(P.ret_w_in, DM, 8192, 4096, 2048, WIN, DM, 4096, 2, scr, lane, gw, NGW, cnt);
        transpose_matrix(P.ret_w_in, DM, 8192, 6144, 2048, WIN, DM, 4096, 3, scr, lane, gw, NGW, cnt);
        transpose_matrix(P.ret_w_o, 2048, DM, 0, DM, WRO, 2048, 0, 0, scr, lane, gw, NGW, cnt);
        for (int l = 0; l < 4; ++l) {
            transpose_matrix(P.ffn_w_gate + (size_t)l * DM * FFH, DM, FFH, 0, FFH, WGU + (size_t)l * 5632 * DM, DM, 0, 2, scr, lane, gw, NGW, cnt);
            transpose_matrix(P.ffn_w_up + (size_t)l * DM * FFH, DM, FFH, 0, FFH, WGU + (size_t)l * 5632 * DM, DM, 0, 3, scr, lane, gw, NGW, cnt);
            transpose_matrix(P.ffn_w_down + (size_t)l * FFH * DM, FFH, DM, 0, DM, WD + (size_t)l * DM * FFH, FFH, 0, 0, scr, lane, gw, NGW, cnt);
        }
        grid.sync();
    }

#pragma unroll 1
    for (int layer = 0; layer < 4; ++layer) {
        const int kind = layer % 3, slot = layer / 3;
        const float* modl = MOD + (size_t)layer * 9 * MODW;
        const int ntm = layer < 3 ? NTILE_M : 256;
        if (layer == 0) { prenorm_phase<true>(P.x, P.ctx, XB, P.norm_mix + layer * DM, modl, 0, 1, H, 0, MTOT, G, bid, wid0); GSYNC(); }
        if (kind == 0) {
            REPEAT(REP_GQKV) {
                pg8::Gemm g{H, WQKV + (size_t)slot * 1536 * DM, DM, DM, DM, 0, 0}; pg8::Sched S; S.init(NTILE_M, 6, G, bid, NTILE_M, 0, 0);
                pg8::EpiAttnQKV E{QKV, P.attn_q_norm + slot * 64, P.attn_k_norm + slot * 64, ROPEA_C, ROPEA_S};
                pg8::gemm_phase(lds, g, S, E, wid0);
                GSYNC();
            }
            REPEAT(REP_ATTN) { attn_phase(lds, QKV, AO, P.attn_sink + slot * 16, layer < 3, G, bid, wid0); GSYNC(); }
            {
                pg8::Gemm g{AO, WAO + (size_t)slot * DM * DM, DM, DM, DM, 0, 0}; pg8::Sched S; S.init(256, 4, G, bid, 256, 0, 0);
                if (layer == 0) { pg8::EpiResid<true, false> E{P.x, P.ctx, XB, P.out, modl + 2 * DM, nullptr}; pg8::gemm_phase(lds, g, S, E, wid0); }
                else { pg8::EpiResid<false, false> E{P.x, P.ctx, XB, P.out, modl + 2 * DM, nullptr}; pg8::gemm_phase(lds, g, S, E, wid0); }
            }
        } else if (kind == 1) {
            REPEAT(REP_NORM) { pool_phase(H, POOLED, G, bid, wid0); GSYNC(); }
            {
                pg8::Gemm g{POOLED, WP, DM, 256, 256, 0, 1}; pg8::Sched S; S.init(256, 4, G, bid, 256, 0, 0);
                pg8::EpiResid<false, false> E{P.x, P.ctx, XB, P.out, modl + 2 * DM, P.pool_scale + slot * DM};
                pg8::gemm_phase(lds, g, S, E, wid0);
            }
        } else {
#pragma unroll 1
            for (int hb = 0; hb < 2; ++hb) {
                const int s0b = hb * 128, s1b = 256 + hb * 4;
                REPEAT(REP_GRQKV) {
                    pg8::Gemm g{H, WIN, DM, DM, DM, 0, 0}; pg8::Sched S; S.init(132, 16, G, bid, 128, s0b, s1b);
                    pg8::EpiRetQKV E{RQ, RV, ROPER_C, ROPER_S, SS};
                    pg8::gemm_phase(lds, g, S, E, wid0);
                    GSYNC();
                }
                {
                    ret_scan_phase(lds, RQ, RV, YF, YB, SS, (unsigned*)(ws + WS_CTL), hb, G, bid, wid0);
                    GSYNC();
                }
                REPEAT(REP_GGATE) {
                    pg8::Gemm g{H, WIN + (size_t)4096 * DM, DM, DM, DM, 0, 0}; pg8::Sched S; S.init(132, 16, G, bid, 128, s0b, s1b);
                    pg8::EpiRetGate E{YF, YB, SS, Z};
                    pg8::gemm_phase(lds, g, S, E, wid0);
                    GSYNC();
                }
                {
                    pg8::Gemm g{Z, WRO, 2048, 2048, 2048, 1, 0}; pg8::Sched S; S.init(132, 4, G, bid, 128, s0b, s1b);
                    pg8::EpiResid<false, false> E{P.x, P.ctx, XB, P.out, modl + 2 * DM, nullptr};
                    pg8::gemm_phase(lds, g, S, E, wid0);
                }
                if (hb == 0) GSYNC();
            }
        }
        GSYNC();
        if (kind != 2 && layer < 3) {
            const int nbc = G >= 64 ? 32 : G / 2;
            if (bid < nbc) {
                pg8::Sched S2; S2.init(8, 4, nbc, bid, 0, 0, 256);
                if (kind == 0) {
                    pg8::Gemm g{AO, WAO + (size_t)slot * DM * DM, DM, DM, DM, 0, 0};
                    if (layer == 0) { pg8::EpiResid<true, false> E{P.x, P.ctx, XB, P.out, modl + 2 * DM, nullptr}; pg8::gemm_phase(lds, g, S2, E, wid0); }
                    else { pg8::EpiResid<false, false> E{P.x, P.ctx, XB, P.out, modl + 2 * DM, nullptr}; pg8::gemm_phase(lds, g, S2, E, wid0); }
                } else {
                    pg8::Gemm g{POOLED, WP, DM, 256, 256, 0, 1};
                    pg8::EpiResid<false, false> E{P.x, P.ctx, XB, P.out, modl + 2 * DM, P.pool_scale + slot * DM}; pg8::gemm_phase(lds, g, S2, E, wid0);
                }
            } else prenorm_phase<false>(P.x, P.ctx, XB, P.norm_ffn + layer * DM, modl, 3, 4, H, 0, MLAT, G - nbc, bid - nbc, wid0);
            GSYNC();
            prenorm_phase<false>(P.x, P.ctx, XB, P.norm_ffn + layer * DM, modl, 3, 4, H, MLAT, MTOT, G, bid, wid0); GSYNC();
        } else { prenorm_phase<false>(P.x, P.ctx, XB, P.norm_ffn + layer * DM, modl, 3, 4, H, 0, ntm * 256, G, bid, wid0); GSYNC(); }
        REPEAT(REP_GGU) {
            pg8::Gemm g{H, WGU + (size_t)layer * 5632 * DM, DM, DM, DM, 0, 0}; pg8::Sched S; S.init(ntm, 22, G, bid, ntm, 0, 0);
            pg8::EpiSwiGLU E{HID};
            pg8::gemm_phase(lds, g, S, E, wid0);
            GSYNC();
        }
        {
            pg8::Gemm g{HID, WD + (size_t)layer * DM * FFH, FFH, FFH, FFH, 0, 0};
            if (layer == 3) {
                pg8::Sched S; S.init(256, 4, G, bid, 256, 0, 0);
                pg8::EpiResid<false, true> E{P.x, P.ctx, XB, P.out, modl + 5 * DM, nullptr}; pg8::gemm_phase(lds, g, S, E, wid0);
                GSYNC();
            } else {
                pg8::EpiResid<false, false> E{P.x, P.ctx, XB, P.out, modl + 5 * DM, nullptr};
                { pg8::Sched S; S.init(256, 4, G, bid, 256, 0, 0); pg8::gemm_phase(lds, g, S, E, wid0); }
                GSYNC();
                const int nbc = G >= 64 ? 32 : G / 2;
                const float* modn = modl + 9 * MODW; const float* gn = P.norm_mix + (layer + 1) * DM;
                if (bid < nbc) { pg8::Sched S; S.init(8, 4, nbc, bid, 0, 0, 256); pg8::gemm_phase(lds, g, S, E, wid0); }
                else prenorm_phase<false>(P.x, P.ctx, XB, gn, modn, 0, 1, H, 0, MLAT, G - nbc, bid - nbc, wid0);
                GSYNC();
                prenorm_phase<false>(P.x, P.ctx, XB, gn, modn, 0, 1, H, MLAT, MTOT, G, bid, wid0);
                GSYNC();
            }
        }
        REPEAT(REP_SYNC) GSYNC();
    }
}

extern "C" void kernel_launch(void* const* d_in, const int* in_sizes, int n_in, void* d_out, int out_size, void* d_ws, size_t ws_size, hipStream_t stream) {
    static int grid_blocks = 0;
    if (grid_blocks == 0) {
        if (n_in != 20 || ws_size < WS_END) { fprintf(stderr, "kernel_launch: unexpected inputs (n_in %d, ws %zu)\n", n_in, ws_size); grid_blocks = -1; return; }
        int dev = 0, cus = 0, per_cu = 0;
        hipGetDevice(&dev);
        hipDeviceGetAttribute(&cus, hipDeviceAttributeMultiprocessorCount, dev);
        if (hipFuncSetAttribute((const void*)fwd_megakernel, hipFuncAttributeMaxDynamicSharedMemorySize, LDS_BYTES) != hipSuccess) { fprintf(stderr, "kernel_launch: hipFuncSetAttribute failed\n"); grid_blocks = -1; return; }
        if (hipOccupancyMaxActiveBlocksPerMultiprocessor(&per_cu, (const void*)fwd_megakernel, 512, LDS_BYTES) != hipSuccess || per_cu < 1) { fprintf(stderr, "kernel_launch: occupancy query failed (%d)\n", per_cu); per_cu = 1; (void)hipGetLastError(); }
        grid_blocks = cus * per_cu;
    }
    if (grid_blocks < 0) return;
    Params p{};
    p.x = (const float*)d_in[0]; p.c = (const float*)d_in[1]; p.ctx = (const float*)d_in[2]; p.c_ctx = (const float*)d_in[3]; p.ada_w = (const float*)d_in[4]; p.ada_b = (const float*)d_in[5];
    p.norm_mix = (const float*)d_in[6]; p.norm_ffn = (const float*)d_in[7]; p.attn_w_qkv = (const float*)d_in[8]; p.attn_w_o = (const float*)d_in[9]; p.attn_q_norm = (const float*)d_in[10];
    p.attn_k_norm = (const float*)d_in[11]; p.attn_sink = (const float*)d_in[12]; p.pool_w = (const float*)d_in[13]; p.pool_scale = (const float*)d_in[14]; p.ret_w_in = (const float*)d_in[15];
    p.ret_w_o = (const float*)d_in[16]; p.ffn_w_gate = (const float*)d_in[17]; p.ffn_w_up = (const float*)d_in[18]; p.ffn_w_down = (const float*)d_in[19];
    p.out = (float*)d_out; p.ws = (unsigned char*)d_ws;
    if (hipMemsetAsync((char*)d_ws + WS_CTL, 0, 32768, stream) != hipSuccess) { fprintf(stderr, "kernel_launch: memset failed\n"); return; }
    void* args[] = {&p};
    hipError_t e = hipLaunchCooperativeKernel((const void*)fwd_megakernel, dim3(grid_blocks), dim3(512), args, LDS_BYTES, stream);
    if (e != hipSuccess) fprintf(stderr, "cooperative launch failed: %s (grid %d)\n", hipGetErrorString(e), grid_blocks);
}
```

```cpp
#include <hip/hip_runtime.h>
#include <hip/hip_cooperative_groups.h>
#include <cstdio>
#include <cstdint>
namespace cg = cooperative_groups;

#define DI __device__ __forceinline__
#define LAS __attribute__((address_space(3)))
typedef unsigned short bf16_t;
typedef short bf16x8 __attribute__((ext_vector_type(8)));
typedef short s16x4 __attribute__((ext_vector_type(4)));
typedef float f32x4 __attribute__((ext_vector_type(4)));
typedef float f32x16 __attribute__((ext_vector_type(16)));
typedef unsigned u32x4 __attribute__((ext_vector_type(4)));
typedef unsigned u32x2 __attribute__((ext_vector_type(2)));
typedef float f32x2_t __attribute__((ext_vector_type(2)));
typedef __bf16 bf16x2_t __attribute__((ext_vector_type(2)));
typedef short v4i16_t __attribute__((ext_vector_type(4)));

DI unsigned pk2(float lo, float hi) { f32x2_t v = {lo, hi}; bf16x2_t b = __builtin_convertvector(v, bf16x2_t); return __builtin_bit_cast(unsigned, b); }
DI float bflo(unsigned w) { return __uint_as_float(w << 16); }
DI float bfhi(unsigned w) { return __uint_as_float(w & 0xffff0000u); }
DI float silu_f(float x) { return x * __builtin_amdgcn_rcpf(1.0f + __expf(-x)); }
DI size_t rfrag(int mat, int rowtile, int s, int r, int hh) { return ((((size_t)mat * 1056 + rowtile) * 16 + s) * 64 + r * 2 + hh) * 8; }
DI int crow(int reg, int h) { return (reg & 3) + 8 * (reg >> 2) + 4 * h; }
DI float shx(float v, int m, int lane) { return __int_as_float(__builtin_amdgcn_ds_bpermute((lane ^ m) << 2, __float_as_int(v))); }
DI float wave_sum(float v, int lane) {
#pragma unroll
    for (int o = 1; o < 64; o <<= 1) v += shx(v, o, lane);
    return v;
}
DI int opaque_tid(int wid0) { int l; asm volatile("v_mbcnt_lo_u32_b32 %0, -1, 0\n\tv_mbcnt_hi_u32_b32 %0, -1, %0" : "=v"(l)); return wid0 * 64 + l; }
DI int opq(int v) { asm volatile("" : "+v"(v)); return v; }
#define LDS_BARRIER() do { asm volatile("s_waitcnt lgkmcnt(0)" ::: "memory"); __builtin_amdgcn_s_barrier(); asm volatile("" ::: "memory"); } while (0)
#define MFMA32(a, b, c) __builtin_amdgcn_mfma_f32_32x32x16_bf16((a), (b), (c), 0, 0, 0)
DI s16x4 trd(const LAS unsigned char* p) { return __builtin_bit_cast(s16x4, __builtin_amdgcn_ds_read_tr16_b64_v4i16((LAS v4i16_t*)p)); }
DI bf16x8 cat8(s16x4 lo, s16x4 hi) { return __builtin_shufflevector(lo, hi, 0, 1, 2, 3, 4, 5, 6, 7); }
DI bf16x8 pack8(const f32x16& x, int s) {
    u32x4 p; p.x = pk2(x[8 * s], x[8 * s + 1]); p.y = pk2(x[8 * s + 2], x[8 * s + 3]); p.z = pk2(x[8 * s + 4], x[8 * s + 5]); p.w = pk2(x[8 * s + 6], x[8 * s + 7]);
    return __builtin_bit_cast(bf16x8, p);
}

constexpr int DM = 1024, NB = 8, SEQ = 8192, CTXL = 256, FFH = 2816;
constexpr int MLAT = NB * SEQ, MCTX = NB * CTXL, MTOT = MLAT + MCTX;
constexpr int NTILE_M = MTOT / 256;
constexpr int MODW = 6 * DM;
constexpr int MHALF = 4 * SEQ + 4 * CTXL;
constexpr float NEPS = 1e-6f;

constexpr size_t MiB = 1u << 20;
constexpr size_t WS_MOD = 0;
constexpr size_t WS_CTL = 896 * 1024;
constexpr size_t WS_ROPEA = 1 * MiB;
constexpr size_t WS_ROPER = 3 * MiB;
constexpr size_t WS_XC = 11 * MiB;
constexpr size_t WS_SS = 19 * MiB;
constexpr size_t WS_ZERO = 35 * MiB + 640 * 1024;
constexpr size_t WS_WQKV = 36 * MiB;
constexpr size_t WS_WAO = 42 * MiB;
constexpr size_t WS_WP = 46 * MiB;
constexpr size_t WS_WIN = 47 * MiB;
constexpr size_t WS_WRO = 63 * MiB;
constexpr size_t WS_WGU = 67 * MiB;
constexpr size_t WS_WD = 111 * MiB;
constexpr size_t WS_H = 133 * MiB;
constexpr size_t WS_BIG = 265 * MiB;
constexpr size_t WS_QKV = WS_BIG;
constexpr size_t WS_AO = WS_BIG + 198 * MiB;
constexpr size_t WS_HID = WS_BIG;
constexpr size_t WS_POOLED = WS_BIG;
constexpr size_t WS_RQKV = WS_BIG;
constexpr size_t WS_YF = WS_BIG + 264 * MiB;
constexpr size_t WS_YB = WS_BIG + 396 * MiB;
constexpr size_t WS_Z = WS_BIG;
constexpr size_t WS_XB = WS_BIG + 528 * MiB;
constexpr size_t WS_END = WS_BIG + 660 * MiB;

constexpr int LDS_BYTES = 147456;

namespace pg8 {
constexpr int STAGGER_TICKS = 35;
constexpr int BM = 256, BK = 64, HALF = 128, HTB = HALF * BK * 2, STAGE_BYTES = 8 * HTB, NXCD = 8, WGM = 8;
DI int lds_byte(int r, int c) { const int st = (r >> 4) * 2 + (c >> 5), rr = r & 15, cc = c & 31, ob = rr * 64 + cc * 2; return st * 1024 + (ob ^ (((ob >> 9) & 1) << 5)); }
DI void stage_rc(int b, int& R, int& C) { const int st = b / 1024, sb = b % 1024, swz = sb ^ (((sb >> 9) & 1) << 5); R = (st >> 1) * 16 + swz / 64; C = (st & 1) * 32 + (swz % 64) / 2; }
DI int perm32(int rho) { const int n = rho >> 4, i = rho & 15; return 8 * (i >> 2) + 4 * n + (i & 3); }

struct Unit { int pm, pn, lt; };
struct Gemm { const bf16_t* A; const bf16_t* Bt; int lda, ldb, K; int a_local; int grouped; };

struct Sched {
    int nM, nN, nwg, G, c, s0n, s0b, s1b;
    DI void init(int nM_, int nN_, int G_, int c_, int s0n_, int s0b_, int s1b_) { nM = nM_; nN = nN_; nwg = nM * nN; G = G_; c = c_; s0n = s0n_; s0b = s0b_; s1b = s1b_; }
    DI bool next(int i, Unit& u) const {
        const long L = (long)i * G + c; if (L >= nwg) return false;
        int wgid = (int)L; { const int q = nwg / NXCD, r = nwg % NXCD, xcd = wgid % NXCD, off = wgid / NXCD; wgid = (xcd < r ? xcd * (q + 1) : r * (q + 1) + (xcd - r) * q) + off; }
        const int nig = WGM * nN, gid = wgid / nig, fm = gid * WGM, gsz = (nM - fm) < WGM ? (nM - fm) : WGM;
        const int t = fm + ((wgid % nig) % gsz); u.pn = (wgid % nig) / gsz; u.lt = t; u.pm = t < s0n ? s0b + t : s1b + (t - s0n); return true;
    }
};

template <class Epi>
DI void gemm_phase(LAS unsigned char* lds, const Gemm g, const Sched& S, const Epi& E, int wid0) {
    const int tid = opaque_tid(wid0), wid = __builtin_amdgcn_readfirstlane(tid >> 6), lane = tid & 63, wr = wid >> 2, wc = wid & 3, fr = lane & 15, fq = lane >> 4;
    const int K = g.K, nt = K / BK;
    unsigned voffA[2], voffB[2];
#pragma unroll
    for (int i = 0; i < 2; ++i) { int R, C; stage_rc(tid * 16 + i * 8192, R, C); const int Rb = Epi::PERM ? ((R & ~31) + perm32(R & 31)) : R;
        voffA[i] = (unsigned)(R * g.lda + C) * 2u; voffB[i] = (unsigned)(Rb * g.ldb + C) * 2u; }
    const size_t kstep = (size_t)(BK * 2);
    const size_t hstepA = (size_t)HALF * g.lda * 2, hstepB = (size_t)HALF * g.ldb * 2;
    const size_t tstepA = 2 * hstepA, tstepB = 2 * hstepB;
    const unsigned ldsw = (unsigned)wid * 1024u;
    const int aoff = lds_byte(wr * 64 + fr, fq * 8), boff = lds_byte(wc * 32 + fr, fq * 8);
#define PG8_SA(b, h) (((b) * 2 + (h)) * HTB)
#define PG8_SB(b, h) ((4 + (b) * 2 + (h)) * HTB)
#define PG8_STAGE(bufoff, gbase, voff) do { _Pragma("unroll") for (int _i = 0; _i < 2; ++_i) \
        __builtin_amdgcn_global_load_lds((const unsigned*)((const char*)(gbase) + (voff)[_i]), (LAS unsigned*)(lds + (bufoff) + ldsw + _i * 8192), 16, 0, 0); } while (0)
#define PG8_LDA(dst, b, h) do { _Pragma("unroll") for (int m = 0; m < 4; ++m) _Pragma("unroll") for (int k = 0; k < 2; ++k) dst[m][k] = *(const LAS bf16x8*)(lds + PG8_SA(b, h) + aoff + m * 2048 + k * 1024); } while (0)
#define PG8_LDB(dst, b, h) do { _Pragma("unroll") for (int n = 0; n < 2; ++n) _Pragma("unroll") for (int k = 0; k < 2; ++k) dst[n][k] = *(const LAS bf16x8*)(lds + PG8_SB(b, h) + boff + n * 2048 + k * 1024); } while (0)
#define PG8_MMA(ai, bj, At, Bt) do { __builtin_amdgcn_s_setprio(1); _Pragma("unroll") for (int m = 0; m < 4; ++m) _Pragma("unroll") for (int n = 0; n < 2; ++n) _Pragma("unroll") for (int k = 0; k < 2; ++k) \
        acc[ai][bj][m][n] = __builtin_amdgcn_mfma_f32_16x16x32_bf16(Bt[n][k], At[m][k], acc[ai][bj][m][n], 0, 0, 0); __builtin_amdgcn_s_setprio(0); } while (0)
#define PG8_WAIT_V(n) asm volatile("s_waitcnt vmcnt(" #n ")" ::: "memory")
#define PG8_WAIT_L(n) asm volatile("s_waitcnt lgkmcnt(" #n ")" ::: "memory")
#define PG8_BAR __builtin_amdgcn_s_barrier()
#define PG8_SCHED __builtin_amdgcn_sched_barrier(0)
#define PG8_APTR(u) ((const char*)g.A + (size_t)(g.a_local ? (u).lt : (u).pm) * tstepA + (g.grouped ? (size_t)(u).pn * K * 2 : (size_t)0))
#define PG8_BPTR(u) ((const char*)g.Bt + (size_t)(u).pn * tstepB)
    Unit cur, nxt; int ui = 0;
    if (!S.next(0, cur)) return;
    if (Epi::STAGGER) {
        const int nmine = (S.nwg - S.c + S.G - 1) / S.G, nmax = (S.nwg + S.G - 1) / S.G;
        if (nmine < nmax) {
            const unsigned long long delay = (unsigned long long)(((S.c >> 3) & 3) * nt * STAGGER_TICKS);
            const unsigned long long t0 = __builtin_amdgcn_s_memrealtime();
            while (__builtin_amdgcn_s_memrealtime() - t0 < delay) __builtin_amdgcn_s_sleep(32);
        }
    }
    f32x4 acc[2][2][4][2];
#pragma unroll
    for (int a = 0; a < 2; ++a)
#pragma unroll
        for (int b = 0; b < 2; ++b)
#pragma unroll
            for (int m = 0; m < 4; ++m)
#pragma unroll
                for (int n = 0; n < 2; ++n) acc[a][b][m][n] = (f32x4){0.f, 0.f, 0.f, 0.f};
    bf16x8 At[4][2], B0[2][2], B1[2][2];
    const char* cA = PG8_APTR(cur); const char* cB = PG8_BPTR(cur);
    PG8_STAGE(PG8_SB(0, 0), cB, voffB); PG8_STAGE(PG8_SB(0, 1), cB + hstepB, voffB); PG8_STAGE(PG8_SA(0, 0), cA, voffA); PG8_STAGE(PG8_SA(0, 1), cA + hstepA, voffA);
    if (wr == 1) PG8_BAR;
    PG8_WAIT_V(2); PG8_BAR;
    PG8_STAGE(PG8_SB(1, 0), cB + kstep, voffB); PG8_STAGE(PG8_SA(1, 0), cA + kstep, voffA); PG8_STAGE(PG8_SB(1, 1), cB + hstepB + kstep, voffB);
    PG8_WAIT_V(6); PG8_BAR;
    for (;;) {
        const bool has_next = S.next(ui + 1, nxt);
        const char* nA = has_next ? PG8_APTR(nxt) : cA; const char* nB = has_next ? PG8_BPTR(nxt) : cB;
        for (int t = 0; t < nt; t += 2) {
            const bool last = (t == nt - 2);
            const char* a1 = cA + (size_t)(t + 1) * kstep;
            const char* a2 = last ? nA : cA + (size_t)(t + 2) * kstep; const char* b2 = last ? nB : cB + (size_t)(t + 2) * kstep;
            const char* a3 = a2 + kstep; const char* b3 = b2 + kstep;
            PG8_LDB(B0, 0, 0); PG8_LDB(B1, 0, 1); PG8_SCHED; PG8_LDA(At, 0, 0); PG8_STAGE(PG8_SA(1, 1), a1 + hstepA, voffA);
            PG8_WAIT_V(8); PG8_WAIT_L(0); PG8_BAR; PG8_MMA(0, 0, At, B0); PG8_MMA(0, 1, At, B1); PG8_BAR; PG8_SCHED;
            PG8_LDA(At, 0, 1); PG8_STAGE(PG8_SB(0, 0), b2, voffB); PG8_STAGE(PG8_SB(0, 1), b2 + hstepB, voffB); PG8_STAGE(PG8_SA(0, 0), a2, voffA);
            PG8_WAIT_V(8); PG8_WAIT_L(0); PG8_BAR; PG8_MMA(1, 0, At, B0); PG8_MMA(1, 1, At, B1); PG8_BAR; PG8_SCHED;
            PG8_LDB(B0, 1, 0); PG8_LDB(B1, 1, 1); PG8_SCHED; PG8_LDA(At, 1, 0); PG8_STAGE(PG8_SA(0, 1), a2 + hstepA, voffA);
            PG8_WAIT_V(8); PG8_WAIT_L(0); PG8_BAR; PG8_MMA(0, 0, At, B0); PG8_MMA(0, 1, At, B1); PG8_BAR; PG8_SCHED;
            PG8_LDA(At, 1, 1); PG8_STAGE(PG8_SB(1, 0), b3, voffB); PG8_STAGE(PG8_SB(1, 1), b3 + hstepB, voffB); PG8_STAGE(PG8_SA(1, 0), a3, voffA);
            PG8_WAIT_V(8); PG8_WAIT_L(0); PG8_BAR; PG8_MMA(1, 0, At, B0); PG8_MMA(1, 1, At, B1); PG8_BAR; PG8_SCHED;
        }
        if (wr == 0) PG8_BAR;
        E(acc, cur, wr, wc, fr, fq);
        if (!has_next) break;
#pragma unroll
        for (int a = 0; a < 2; ++a)
#pragma unroll
            for (int b = 0; b < 2; ++b)
#pragma unroll
                for (int m = 0; m < 4; ++m)
#pragma unroll
                    for (int n = 0; n < 2; ++n) acc[a][b][m][n] = (f32x4){0.f, 0.f, 0.f, 0.f};
        cur = nxt; cA = nA; cB = nB; ++ui;
        if (wr == 1) PG8_BAR;
    }
    PG8_WAIT_V(0);
    PG8_BAR;
#undef PG8_SA
#undef PG8_SB
#undef PG8_STAGE
#undef PG8_LDA
#undef PG8_LDB
#undef PG8_MMA
#undef PG8_WAIT_V
#undef PG8_WAIT_L
#undef PG8_BAR
#undef PG8_SCHED
#undef PG8_APTR
#undef PG8_BPTR
}

typedef f32x4 Acc[2][2][4][2];

template <bool BF32, bool OF32>
struct EpiResid {
    static constexpr bool PERM = false, STAGGER = false;
    const float* base_l; const float* base_c; bf16_t* XBp; float* outf; const float* gate; const float* colscale;
    DI void operator()(const Acc& acc, const Unit& u, int wr, int wc, int fr, int fq) const {
        const bool lat = u.pm < 256; const int bb = lat ? (u.pm >> 5) : 8;
        const size_t rowt = lat ? (size_t)u.pm * 256 : (size_t)(u.pm - 256) * 256;
        const float* bp = (lat ? base_l : base_c) + rowt * DM;
        bf16_t* xp = XBp + (size_t)u.pm * 256 * DM; float* op = outf + (size_t)u.pm * 256 * DM;
        const float* gp = gate + bb * MODW;
        const int col0 = u.pn * 256 + wc * 32 + 4 * fq;
        f32x4 gv[2][2];
#pragma unroll
        for (int bj = 0; bj < 2; ++bj)
#pragma unroll
            for (int n = 0; n < 2; ++n) {
                const int c = col0 + bj * 128 + n * 16;
                gv[bj][n] = *(const f32x4*)(gp + c);
                if (colscale) gv[bj][n] = gv[bj][n] * *(const f32x4*)(colscale + c);
            }
        constexpr int PD = 3;
        f32x4 buf[PD + 1][4]; u32x2 bufh[PD + 1][4];
#define ER_LOAD(g_) do { const int bj_ = (g_) >> 2, n_ = ((g_) >> 1) & 1, ai_ = (g_) & 1; const int c_ = col0 + bj_ * 128 + n_ * 16; const int frx_ = opq(fr); \
            _Pragma("unroll") for (int m_ = 0; m_ < 4; ++m_) { const size_t o_ = (size_t)(ai_ * 128 + wr * 64 + m_ * 16 + frx_) * DM + c_; \
                if (BF32) buf[(g_) & PD][m_] = *(const f32x4*)(bp + o_); else bufh[(g_) & PD][m_] = *(const u32x2*)(xp + o_); } } while (0)
#pragma unroll
        for (int g = 0; g < PD; ++g) ER_LOAD(g);
#pragma unroll
        for (int g = 0; g < 8; ++g) {
            const int bj = g >> 2, n = (g >> 1) & 1, ai = g & 1;
            const int c = col0 + bj * 128 + n * 16;
            if (g + PD < 8) ER_LOAD(g + PD);
            asm volatile("" ::: "memory");
            {
                const int frx = opq(fr);
#pragma unroll
                for (int m = 0; m < 4; ++m) {
                    const size_t o_ = (size_t)(ai * 128 + wr * 64 + m * 16 + frx) * DM + c;
                    f32x4 bv;
                    if (BF32) bv = buf[g & PD][m]; else { const u32x2 hw = bufh[g & PD][m]; bv = (f32x4){bflo(hw.x), bfhi(hw.x), bflo(hw.y), bfhi(hw.y)}; }
                    const f32x4 o = bv + acc[ai][bj][m][n] * gv[bj][n];
                    if (OF32) *(f32x4*)(op + o_) = o; else { u32x2 w; w.x = pk2(o[0], o[1]); w.y = pk2(o[2], o[3]); *(u32x2*)(xp + o_) = w; }
                }
            }
            asm volatile("" ::: "memory");
        }
#undef ER_LOAD
    }
};

struct EpiSwiGLU {
    static constexpr bool PERM = true, STAGGER = false;
    bf16_t* HID;
    DI void operator()(const Acc& acc, const Unit& u, int wr, int wc, int fr, int fq) const {
        const int hc0 = u.pn * 128 + wc * 32 + 8 * fq;
#pragma unroll
        for (int ai = 0; ai < 2; ++ai)
#pragma unroll
            for (int m = 0; m < 4; ++m) {
                const f32x4 g0 = acc[ai][0][m][0], g1 = acc[ai][0][m][1], u0 = acc[ai][1][m][0], u1 = acc[ai][1][m][1];
                const size_t row0 = (size_t)u.pm * 256 + wr * 64 + opq(fr);
                u32x4 w;
                w.x = pk2(silu_f(g0[0]) * u0[0], silu_f(g0[1]) * u0[1]); w.y = pk2(silu_f(g0[2]) * u0[2], silu_f(g0[3]) * u0[3]);
                w.z = pk2(silu_f(g1[0]) * u1[0], silu_f(g1[1]) * u1[1]); w.w = pk2(silu_f(g1[2]) * u1[2], silu_f(g1[3]) * u1[3]);
                *(u32x4*)(HID + (row0 + ai * 128 + m * 16) * FFH + hc0) = w;
                asm volatile("" ::: "memory");
            }
    }
};

struct EpiAttnQKV {
    static constexpr bool PERM = true, STAGGER = false;
    bf16_t* QKV; const float* qg; const float* kg; const float* cosT; const float* sinT;
    DI void operator()(const Acc& acc, const Unit& u, int wr, int wc, int fr, int fq) const {
        const int mode = u.pn < 4 ? 0 : (u.pn == 4 ? 1 : 2);
        const bool lat = u.pm < 256; const int tok0 = (u.pm * 256) & (SEQ - 1);
        const int jb = 8 * fq;
        const float* gp = mode == 0 ? qg : kg;
        f32x4 gn[2][2];
#pragma unroll
        for (int bj = 0; bj < 2; ++bj)
#pragma unroll
            for (int n = 0; n < 2; ++n) gn[bj][n] = *(const f32x4*)(gp + 32 * bj + jb + 4 * n);
        const int outcol = (mode == 0 ? u.pn * 256 : (mode == 1 ? 1024 : 1280)) + wc * 64 + jb;
        const bool rot = mode < 2 && lat;
        f32x4 cb[3][2], sb[3][2];
#define AQ_LOADCS(i_) do { const int t_ = tok0 + ((i_) >> 2) * 128 + wr * 64 + ((i_) & 3) * 16 + opq(fr); \
            _Pragma("unroll") for (int n_ = 0; n_ < 2; ++n_) { cb[(i_) % 2][n_] = *(const f32x4*)(cosT + t_ * 32 + jb + 4 * n_); sb[(i_) % 2][n_] = *(const f32x4*)(sinT + t_ * 32 + jb + 4 * n_); } } while (0)
        if (rot) { AQ_LOADCS(0); }
#pragma unroll
        for (int ai = 0; ai < 2; ++ai)
#pragma unroll
            for (int m = 0; m < 4; ++m) {
                const int rl = ai * 128 + wr * 64 + m * 16 + opq(fr);
                f32x4 csc[2], snc[2];
#pragma unroll
                for (int n = 0; n < 2; ++n) { csc[n] = cb[(ai * 4 + m) % 2][n]; snc[n] = sb[(ai * 4 + m) % 2][n]; }
                if (rot && ai * 4 + m + 1 < 8) AQ_LOADCS(ai * 4 + m + 1);
                f32x4 v[2][2];
#pragma unroll
                for (int bj = 0; bj < 2; ++bj)
#pragma unroll
                    for (int n = 0; n < 2; ++n) v[bj][n] = acc[ai][bj][m][n];
                if (mode < 2) {
                    float ss = 0.f;
#pragma unroll
                    for (int bj = 0; bj < 2; ++bj)
#pragma unroll
                        for (int n = 0; n < 2; ++n) { const f32x4 x = v[bj][n]; ss += (x[0] * x[0] + x[1] * x[1]) + (x[2] * x[2] + x[3] * x[3]); }
                    { const int ln = fr + 16 * fq; ss += shx(ss, 16, ln); ss += shx(ss, 32, ln); }
                    float rs = rsqrtf(ss * (1.0f / 64.0f) + NEPS); if (mode == 0) rs *= 0.125f * 1.4426950408889634f;
#pragma unroll
                    for (int bj = 0; bj < 2; ++bj)
#pragma unroll
                        for (int n = 0; n < 2; ++n) v[bj][n] = v[bj][n] * rs * gn[bj][n];
                    if (lat) {
#pragma unroll
                        for (int n = 0; n < 2; ++n) {
                            const f32x4 cs = csc[n], sn = snc[n];
                            const f32x4 x1 = v[0][n], x2 = v[1][n];
                            v[0][n] = x1 * cs - x2 * sn; v[1][n] = x2 * cs + x1 * sn;
                        }
                    }
                }
                bf16_t* rp = QKV + ((size_t)u.pm * 256 + rl) * 1536 + outcol;
#pragma unroll
                for (int bj = 0; bj < 2; ++bj) {
                    u32x4 w; w.x = pk2(v[bj][0][0], v[bj][0][1]); w.y = pk2(v[bj][0][2], v[bj][0][3]); w.z = pk2(v[bj][1][0], v[bj][1][1]); w.w = pk2(v[bj][1][2], v[bj][1][3]);
                    *(u32x4*)(rp + 32 * bj) = w;
                }
                asm volatile("" ::: "memory");
            }
#undef AQ_LOADCS
    }
};

struct EpiRetQKV {
    static constexpr bool PERM = true, STAGGER = false;
    bf16_t* RQp; bf16_t* RVp; const float* cosT; const float* sinT; float* SSp;
    DI void operator()(const Acc& acc, const Unit& u, int wr, int wc, int fr, int fq) const {
        const bool lat = u.pm < 256; const int tok0 = (u.pm * 256) & (SEQ - 1);
        const int j0 = 32 * wc + 8 * fq;
        const float sc = (u.pn >= 4 && u.pn < 8) ? 0.0625f : 1.0f;
        if (u.pn == 0) { float zf = 0.f; asm volatile("" : "+v"(zf)); *(f32x4*)(SSp + (size_t)u.lt * 256 * 8 + ((wr * 4 + wc) * 64 + fq * 16 + fr) * 4) = (f32x4){zf, zf, zf, zf}; }
        const bool rot = u.pn < 8 && lat;
        f32x4 cb[3][2], sb[3][2];
#define RQ_LOADCS(i_) do { const int t_ = tok0 + ((i_) >> 2) * 128 + wr * 64 + ((i_) & 3) * 16 + opq(fr); \
            _Pragma("unroll") for (int n_ = 0; n_ < 2; ++n_) { cb[(i_) % 3][n_] = *(const f32x4*)(cosT + t_ * 128 + j0 + 4 * n_); sb[(i_) % 3][n_] = *(const f32x4*)(sinT + t_ * 128 + j0 + 4 * n_); } } while (0)
        if (rot) { RQ_LOADCS(0); RQ_LOADCS(1); }
#pragma unroll
        for (int ai = 0; ai < 2; ++ai)
#pragma unroll
            for (int m = 0; m < 4; ++m) {
                const int rl = ai * 128 + wr * 64 + m * 16 + opq(fr);
                if (rot && ai * 4 + m + 2 < 8) RQ_LOADCS(ai * 4 + m + 2);
                f32x4 v[2][2];
#pragma unroll
                for (int bj = 0; bj < 2; ++bj)
#pragma unroll
                    for (int n = 0; n < 2; ++n) v[bj][n] = acc[ai][bj][m][n] * sc;
                if (u.pn < 8 && lat) {
#pragma unroll
                    for (int n = 0; n < 2; ++n) {
                        const f32x4 cs = cb[(ai * 4 + m) % 3][n], sn = sb[(ai * 4 + m) % 3][n];
                        const f32x4 x1 = v[0][n], x2 = v[1][n];
                        v[0][n] = x1 * cs - x2 * sn; v[1][n] = x2 * cs + x1 * sn;
                    }
                }
                const int lrow = u.lt * 256 + rl;
#pragma unroll
                for (int bj = 0; bj < 2; ++bj) {
                    u32x4 w; w.x = pk2(v[bj][0][0], v[bj][0][1]); w.y = pk2(v[bj][0][2], v[bj][0][3]); w.z = pk2(v[bj][1][0], v[bj][1][1]); w.w = pk2(v[bj][1][2], v[bj][1][3]);
                    bf16_t* rp = u.pn < 8 ? RQp + rfrag(u.pn, lrow >> 5, 8 * bj + 2 * wc + (fq >> 1), lrow & 31, fq & 1)
                                          : RVp + (size_t)lrow * 2048 + (u.pn - 8) * 256 + 128 * bj + j0;
                    *(u32x4*)rp = w;
                }
                asm volatile("" ::: "memory");
            }
#undef RQ_LOADCS
    }
};

struct EpiRetGate {
    static constexpr bool PERM = true, STAGGER = false;
    const bf16_t* YF; const bf16_t* YB; const float* SS; bf16_t* Z;
    DI void operator()(const Acc& acc, const Unit& u, int wr, int wc, int fr, int fq) const {
        const int c0 = u.pn * 128 + 32 * wc + 8 * fq, head = u.pn >> 2;
        u32x4 yfb[3], ybb[3]; f32x2_t ssb[3];
#define RG_LOAD(i_) do { const size_t lr_ = (size_t)u.lt * 256 + ((i_) >> 2) * 128 + wr * 64 + ((i_) & 3) * 16 + opq(fr); \
            ssb[(i_) % 3] = *(const f32x2_t*)(SS + (lr_ * 4 + head) * 2); yfb[(i_) % 3] = *(const u32x4*)(YF + lr_ * 2048 + c0); ybb[(i_) % 3] = *(const u32x4*)(YB + lr_ * 2048 + c0); } while (0)
        RG_LOAD(0); RG_LOAD(1);
#pragma unroll
        for (int ai = 0; ai < 2; ++ai)
#pragma unroll
            for (int m = 0; m < 4; ++m) {
                const size_t lrow = (size_t)u.lt * 256 + ai * 128 + wr * 64 + m * 16 + opq(fr);
                if (ai * 4 + m + 2 < 8) RG_LOAD(ai * 4 + m + 2);
                const f32x2_t sq = ssb[(ai * 4 + m) % 3];
                const float rf = rsqrtf(sq.x * (1.0f / 512.0f) + NEPS), rb = rsqrtf(sq.y * (1.0f / 512.0f) + NEPS);
                const u32x4 yf = yfb[(ai * 4 + m) % 3], yb = ybb[(ai * 4 + m) % 3];
                const f32x4 f0 = acc[ai][0][m][0], f1 = acc[ai][0][m][1], b0 = acc[ai][1][m][0], b1 = acc[ai][1][m][1];
                u32x4 w;
                w.x = pk2(silu_f(f0[0]) * bflo(yf.x) * rf + silu_f(b0[0]) * bflo(yb.x) * rb, silu_f(f0[1]) * bfhi(yf.x) * rf + silu_f(b0[1]) * bfhi(yb.x) * rb);
                w.y = pk2(silu_f(f0[2]) * bflo(yf.y) * rf + silu_f(b0[2]) * bflo(yb.y) * rb, silu_f(f0[3]) * bfhi(yf.y) * rf + silu_f(b0[3]) * bfhi(yb.y) * rb);
                w.z = pk2(silu_f(f1[0]) * bflo(yf.z) * rf + silu_f(b1[0]) * bflo(yb.z) * rb, silu_f(f1[1]) * bfhi(yf.z) * rf + silu_f(b1[1]) * bfhi(yb.z) * rb);
                w.w = pk2(silu_f(f1[2]) * bflo(yf.w) * rf + silu_f(b1[2]) * bflo(yb.w) * rb, silu_f(f1[3]) * bfhi(yf.w) * rf + silu_f(b1[3]) * bfhi(yb.w) * rb);
                *(u32x4*)(Z + lrow * 2048 + c0) = w;
                asm volatile("" ::: "memory");
            }
#undef RG_LOAD
    }
};
}

struct Params {
    const float* x; const float* c; const float* ctx; const float* c_ctx; const float* ada_w; const float* ada_b; const float* norm_mix; const float* norm_ffn;
    const float* attn_w_qkv; const float* attn_w_o; const float* attn_q_norm; const float* attn_k_norm; const float* attn_sink;
    const float* pool_w; const float* pool_scale; const float* ret_w_in; const float* ret_w_o; const float* ffn_w_gate; const float* ffn_w_up; const float* ffn_w_down;
    float* out; unsigned char* ws;
};

DI void transpose_item(const float* W, int ldw, int k0, int col0, bf16_t* dst, int ldd, int drow0, LAS float* scr, int lane) {
#pragma unroll 8
    for (int i = 0; i < 32; ++i) { const int kk = 2 * i + (lane >> 5); scr[kk * 33 + (lane & 31)] = W[(size_t)(k0 + kk) * ldw + col0 + (lane & 31)]; }
    asm volatile("s_waitcnt lgkmcnt(0)" ::: "memory");
    const int c = lane & 7;
#pragma unroll
    for (int j = 0; j < 4; ++j) { const int n = (lane >> 3) + 8 * j; const LAS float* s = scr + (8 * c) * 33 + n;
        u32x4 o; o.x = pk2(s[0 * 33], s[1 * 33]); o.y = pk2(s[2 * 33], s[3 * 33]); o.z = pk2(s[4 * 33], s[5 * 33]); o.w = pk2(s[6 * 33], s[7 * 33]);
        *(u32x4*)(dst + (size_t)(drow0 + n) * ldd + k0 + 8 * c) = o; }
    asm volatile("s_waitcnt lgkmcnt(0)" ::: "memory");
}
DI int dst_row_of(int kind, int n0) {
    if (kind == 0) return n0;
    if (kind == 1) return (n0 & ~255) + 128 * ((n0 >> 5) & 1) + 32 * ((n0 >> 6) & 3);
    return 256 * (n0 >> 7) + (n0 & 127) + (kind == 3 ? 128 : 0);
}
DI void transpose_matrix(const float* W, int K, int ldw, int col_off, int ncols, bf16_t* dst, int ldd, int drow_off, int kind, LAS float* scr, int lane, int gw, int NGW, int& cnt) {
    const int nblk = ncols / 32, nitems = (K / 64) * nblk;
    int first = (gw - (cnt % NGW) + NGW) % NGW;
    for (int it = first; it < nitems; it += NGW) {
        const int kb = it / nblk, nb = it % nblk;
        transpose_item(W, ldw, 64 * kb, col_off + 32 * nb, dst, ldd, drow_off + dst_row_of(kind, 32 * nb), scr, lane);
    }
    cnt += nitems;
}

template <bool SRCF32>
DI void prenorm_phase(const float* xl, const float* xc, const bf16_t* XBp, const float* gain, const float* modl, int shi, int sci, bf16_t* H, int rbeg, int mrows, int G, int bid, int wid0) {
    const int tid = opaque_tid(wid0), lane = tid & 63, gw = bid * 8 + __builtin_amdgcn_readfirstlane(tid >> 6), NGW = G * 8;
    constexpr int RW = 4;
    for (int row0 = rbeg + gw * RW; row0 < mrows; row0 += NGW * RW) {
        const bool lat = row0 < MLAT; const int bb = lat ? (row0 >> 13) : 8;
        const float* mp = modl + bb * MODW;
        float s[RW]; float zf = 0.f; asm volatile("" : "+v"(zf)); float epsv = NEPS; asm volatile("" : "+v"(epsv));
        if (SRCF32) {
            const float* src = lat ? xl + (size_t)row0 * DM : xc + (size_t)(row0 - MLAT) * DM;
            f32x4 v[RW][4];
#pragma unroll
            for (int q = 0; q < RW; ++q) {
                s[q] = zf;
#pragma unroll
                for (int j = 0; j < 4; ++j) v[q][j] = *(const f32x4*)(src + (size_t)q * DM + 256 * j + 4 * lane);
            }
#pragma unroll
            for (int q = 0; q < RW; ++q)
#pragma unroll
                for (int j = 0; j < 4; ++j) s[q] += (v[q][j][0] * v[q][j][0] + v[q][j][1] * v[q][j][1]) + (v[q][j][2] * v[q][j][2] + v[q][j][3] * v[q][j][3]);
#pragma unroll
            for (int o = 1; o < 64; o <<= 1)
#pragma unroll
                for (int q = 0; q < RW; ++q) s[q] += shx(s[q], o, lane);
#pragma unroll
            for (int j = 0; j < 4; ++j) {
                const int col = 256 * j + 4 * lane;
                const f32x4 g = *(const f32x4*)(gain + col), sc = *(const f32x4*)(mp + sci * DM + col), sh = *(const f32x4*)(mp + shi * DM + col);
                const f32x4 gs = g * (sc + 1.0f);
#pragma unroll
                for (int q = 0; q < RW; ++q) {
                    const float rstd = rsqrtf(s[q] * (1.0f / DM) + epsv);
                    const f32x4 o = v[q][j] * rstd * gs + sh;
                    u32x2 w; w.x = pk2(o[0], o[1]); w.y = pk2(o[2], o[3]);
                    *(u32x2*)(H + (size_t)(row0 + q) * DM + col) = w;
                }
            }
        } else {
            const bf16_t* src = XBp + (size_t)row0 * DM;
            u32x4 v[RW][2];
#pragma unroll
            for (int q = 0; q < RW; ++q) {
                s[q] = zf;
#pragma unroll
                for (int j = 0; j < 2; ++j) v[q][j] = __builtin_nontemporal_load((const u32x4*)(src + (size_t)q * DM + 512 * j + 8 * lane));
            }
#pragma unroll
            for (int q = 0; q < RW; ++q)
#pragma unroll
                for (int j = 0; j < 2; ++j) {
                    const u32x4 w = v[q][j];
                    const float a0 = bflo(w.x), a1 = bfhi(w.x), a2 = bflo(w.y), a3 = bfhi(w.y), a4 = bflo(w.z), a5 = bfhi(w.z), a6 = bflo(w.w), a7 = bfhi(w.w);
                    s[q] += ((a0 * a0 + a1 * a1) + (a2 * a2 + a3 * a3)) + ((a4 * a4 + a5 * a5) + (a6 * a6 + a7 * a7));
                }
#pragma unroll
            for (int o = 1; o < 64; o <<= 1)
#pragma unroll
                for (int q = 0; q < RW; ++q) s[q] += shx(s[q], o, lane);
#pragma unroll
            for (int j = 0; j < 2; ++j) {
                const int col = 512 * j + 8 * lane;
                f32x4 gs[2], sh[2];
#pragma unroll
                for (int t = 0; t < 2; ++t) { gs[t] = *(const f32x4*)(gain + col + 4 * t) * (*(const f32x4*)(mp + sci * DM + col + 4 * t) + 1.0f); sh[t] = *(const f32x4*)(mp + shi * DM + col + 4 * t); }
#pragma unroll
                for (int q = 0; q < RW; ++q) {
                    const float rstd = rsqrtf(s[q] * (1.0f / DM) + epsv);
                    const u32x4 w = v[q][j];
                    const f32x4 x0 = (f32x4){bflo(w.x), bfhi(w.x), bflo(w.y), bfhi(w.y)}, x1 = (f32x4){bflo(w.z), bfhi(w.z), bflo(w.w), bfhi(w.w)};
                    const f32x4 o0 = x0 * rstd * gs[0] + sh[0], o1 = x1 * rstd * gs[1] + sh[1];
                    u32x4 ow; ow.x = pk2(o0[0], o0[1]); ow.y = pk2(o0[2], o0[3]); ow.z = pk2(o1[0], o1[1]); ow.w = pk2(o1[2], o1[3]);
                    *(u32x4*)(H + (size_t)(row0 + q) * DM + col) = ow;
                }
            }
        }
    }
}
template <int HW>
DI void pool_item(const bf16_t* Hn, bf16_t* Pq, int row, int c8) {
    int t, T, rbase;
    if (row < MLAT) { t = row & (SEQ - 1); T = SEQ; rbase = row - t; } else { t = (row - MLAT) & (CTXL - 1); T = CTXL; rbase = row - t; }
    u32x4 w[2 * HW];
#pragma unroll
    for (int k = 0; k < 2 * HW; ++k) { int tt = t - HW + k; tt = tt < 0 ? 0 : (tt > T - 1 ? T - 1 : tt); w[k] = *(const u32x4*)(Hn + (size_t)(rbase + tt) * DM + c8); }
    float a[8]; float cnt = 0.f;
#pragma unroll
    for (int e = 0; e < 8; ++e) a[e] = 0.f;
#pragma unroll
    for (int k = 0; k < 2 * HW; ++k) {
        const int tt = t - HW + k; const float m = (tt >= 0 && tt < T) ? 1.0f : 0.0f; cnt += m;
        a[0] += bflo(w[k].x) * m; a[1] += bfhi(w[k].x) * m; a[2] += bflo(w[k].y) * m; a[3] += bfhi(w[k].y) * m; a[4] += bflo(w[k].z) * m; a[5] += bfhi(w[k].z) * m; a[6] += bflo(w[k].w) * m; a[7] += bfhi(w[k].w) * m;
    }
    const float inv = 1.0f / cnt; const u32x4 c = w[HW];
    u32x4 o;
    o.x = pk2(a[0] * inv - bflo(c.x), a[1] * inv - bfhi(c.x)); o.y = pk2(a[2] * inv - bflo(c.y), a[3] * inv - bfhi(c.y));
    o.z = pk2(a[4] * inv - bflo(c.z), a[5] * inv - bfhi(c.z)); o.w = pk2(a[6] * inv - bflo(c.w), a[7] * inv - bfhi(c.w));
    *(u32x4*)(Pq + (size_t)row * DM + c8) = o;
}
DI void pool_phase(const bf16_t* H, bf16_t* P, int G, int bid, int wid0) {
    const int tid = opaque_tid(wid0), lane = tid & 63, gw = bid * 8 + __builtin_amdgcn_readfirstlane(tid >> 6), NGW = G * 8;
    for (int wi = gw; wi < (MTOT / 2) * 4; wi += NGW) {
        const int rp = wi >> 2, grp = wi & 3, row = 2 * rp + (lane >> 5), c8 = grp * 256 + (lane & 31) * 8;
        if (grp == 0) pool_item<1>(H, P, row, c8); else if (grp == 1) pool_item<2>(H, P, row, c8); else if (grp == 2) pool_item<4>(H, P, row, c8); else pool_item<8>(H, P, row, c8);
    }
}

constexpr int AT_KOFF = 0, AT_VOFF = 128 * 144, AT_PITCH = 144, AT_VPITCH = 192;
DI void attn_phase(LAS unsigned char* lds, const bf16_t* QKV, bf16_t* AO, const float* sink, bool do_ctx, int G, int bid, int wid0) {
    const int tid = opaque_tid(wid0), lane = tid & 63, wid = __builtin_amdgcn_readfirstlane(tid >> 6);
    const int r = lane & 31, hh = lane >> 5, i16 = lane & 15, q4 = i16 >> 2, p4 = i16 & 3, blk = (lane >> 4) & 1;
    const int nunits = 2048 + (do_ctx ? 64 : 0);
    const int vcu = (G % 8 == 0) ? (bid % 8) * (G / 8) + bid / 8 : bid;
    for (int u = vcu; u < nunits; u += G) {
        int b, kvh, qb; bool isctx;
        if (u < 2048) { b = u >> 8; kvh = (u >> 6) & 3; qb = u & 63; isctx = false; } else { const int v = u - 2048; b = v >> 3; kvh = (v >> 1) & 3; qb = v & 1; isctx = true; }
        const size_t qrow0 = isctx ? (size_t)(MLAT + b * CTXL + qb * 128) : (size_t)(b * SEQ + qb * 128);
        const int g = wid >> 1, qh = wid & 1, head = kvh * 4 + g;
        bf16x8 qf[2][4];
#pragma unroll
        for (int qt = 0; qt < 2; ++qt)
#pragma unroll
            for (int s = 0; s < 4; ++s) qf[qt][s] = *(const bf16x8*)(QKV + (qrow0 + qh * 64 + qt * 32 + r) * 1536 + head * 64 + 16 * s + 8 * hh);
        f32x16 o[2][2]; float l[2] = {0.f, 0.f};
#pragma unroll
        for (int a = 0; a < 2; ++a)
#pragma unroll
            for (int c = 0; c < 2; ++c)
#pragma unroll
                for (int e = 0; e < 16; ++e) o[a][c][e] = 0.f;
#define AT_VALID(c_) ((c_) >= 3 || (!isctx && (qb - 1 + (c_)) >= 0 && (qb - 1 + (c_)) <= 63))
#define AT_KROW(c_) ((c_) < 3 ? (size_t)(b * SEQ + (qb - 1 + (c_)) * 128) : (size_t)(MLAT + b * CTXL + ((c_) - 3) * 128))
#define AT_LOAD(c_) do { const size_t kr_ = AT_KROW(c_); _Pragma("unroll") for (int i_ = 0; i_ < 2; ++i_) { const int p_ = tid + 512 * i_, row_ = p_ >> 3, ch_ = p_ & 7; \
            kreg[i_] = *(const u32x4*)(QKV + (kr_ + row_) * 1536 + 1024 + kvh * 64 + ch_ * 8); vreg[i_] = *(const u32x4*)(QKV + (kr_ + row_) * 1536 + 1280 + kvh * 64 + ch_ * 8); } } while (0)
        u32x4 kreg[2], vreg[2];
        int c = 0; while (!AT_VALID(c)) ++c;
        AT_LOAD(c);
        while (c < 5) {
            LDS_BARRIER();
#pragma unroll
            for (int i = 0; i < 2; ++i) {
                const int p = tid + 512 * i, row = p >> 3, ch = p & 7;
                *(LAS u32x4*)(lds + AT_KOFF + row * AT_PITCH + ch * 16) = kreg[i];
                *(LAS u32x4*)(lds + AT_VOFF + row * AT_VPITCH + ch * 16) = vreg[i];
            }
            int cn = c + 1; while (cn < 5 && !AT_VALID(cn)) ++cn;
            if (cn < 5) AT_LOAD(cn);
            LDS_BARRIER();
            const int relbase = (c - 1) * 128;
#pragma unroll 1
            for (int kb32 = 0; kb32 < 4; ++kb32) {
                bf16x8 kf[4];
#pragma unroll
                for (int s = 0; s < 4; ++s) kf[s] = *(const LAS bf16x8*)(lds + AT_KOFF + (kb32 * 32 + r) * AT_PITCH + (16 * s + 8 * hh) * 2);
                bf16x8 vf[2][2];
#pragma unroll
                for (int dt = 0; dt < 2; ++dt)
#pragma unroll
                    for (int s2 = 0; s2 < 2; ++s2) {
                        const LAS unsigned char* vp = lds + AT_VOFF + (kb32 * 32 + 16 * s2 + 4 * hh + q4) * AT_VPITCH + (dt * 32 + 16 * blk) * 2 + 8 * p4;
                        vf[dt][s2] = cat8(trd(vp), trd(vp + 8 * AT_VPITCH));
                    }
#pragma unroll
                for (int qt = 0; qt < 2; ++qt) {
                    const int qlo = qh * 64 + qt * 32;
                    if (c == 0 && kb32 * 32 + 31 < qlo) continue;
                    if (c == 2 && kb32 * 32 > qlo + 31) continue;
                    f32x16 sa;
#pragma unroll
                    for (int e = 0; e < 16; ++e) sa[e] = 0.f;
#pragma unroll
                    for (int s = 0; s < 4; ++s) sa = MFMA32(kf[s], qf[qt][s], sa);
                    const int qi = qlo + r;
                    float ls = 0.f;
                    if (c == 0 || c == 2) {
#pragma unroll
                        for (int e = 0; e < 16; ++e) {
                            float p = __builtin_amdgcn_exp2f(sa[e]);
                            const int rel = relbase + kb32 * 32 + crow(e, hh) - qi; if (rel > 128 || rel < -128) p = 0.f;
                            sa[e] = p; ls += p;
                        }
                    } else {
#pragma unroll
                        for (int e = 0; e < 16; ++e) { const float p = __builtin_amdgcn_exp2f(sa[e]); sa[e] = p; ls += p; }
                    }
                    l[qt] += ls;
                    const bf16x8 p0 = pack8(sa, 0), p1 = pack8(sa, 1);
#pragma unroll
                    for (int dt = 0; dt < 2; ++dt) { o[dt][qt] = MFMA32(vf[dt][0], p0, o[dt][qt]); o[dt][qt] = MFMA32(vf[dt][1], p1, o[dt][qt]); }
                }
            }
            c = cn;
        }
#undef AT_VALID
#undef AT_KROW
#undef AT_LOAD
        const float es = __expf(sink[head]);
#pragma unroll
        for (int qt = 0; qt < 2; ++qt) {
            const float lt = l[qt] + shx(l[qt], 32, lane) + es;
            const float inv = 1.0f / lt;
            bf16_t* op = AO + (qrow0 + qh * 64 + qt * 32 + r) * DM + head * 64;
#pragma unroll
            for (int dt = 0; dt < 2; ++dt)
#pragma unroll
                for (int g4 = 0; g4 < 4; ++g4) {
                    u32x2 w; w.x = pk2(o[dt][qt][4 * g4] * inv, o[dt][qt][4 * g4 + 1] * inv); w.y = pk2(o[dt][qt][4 * g4 + 2] * inv, o[dt][qt][4 * g4 + 3] * inv);
                    *(u32x2*)(op + dt * 32 + 8 * g4 + 4 * hh) = w;
                }
        }
    }
}

DI float ret_log2g(int h, int dir) { return log2f(1.0f - exp2f(-5.0f - (dir ? 0.5f : 0.0f) - (float)h)); }
constexpr int RI_PITCH = 1040;
DI void ret_intra_phase(LAS unsigned char* lds, const bf16_t* RQp, const bf16_t* RVp, bf16_t* YF, bf16_t* YB, int G, int bid, int wid0) {
    const int tid = opaque_tid(wid0), lane = tid & 63, wid = __builtin_amdgcn_readfirstlane(tid >> 6);
    const int r = lane & 31, hh = lane >> 5, i16 = lane & 15, q4 = i16 >> 2, p4 = i16 & 3, blk = (lane >> 4) & 1;
    const int it = wid & 3, dir = wid >> 2;
    for (int u = bid; u < 1056; u += G) {
        const int b4 = u / 264, rem = u % 264, h = rem / 66, ch = rem % 66;
        const size_t lrow0 = ch < 64 ? (size_t)(b4 * SEQ + ch * 128) : (size_t)(4 * SEQ + b4 * CTXL + (ch - 64) * 128);
        __syncthreads();
#pragma unroll 4
        for (int i = 0; i < 16; ++i) {
            const int p = tid + 512 * i, row = p >> 6, cn = p & 63;
            *(LAS u32x4*)(lds + row * RI_PITCH + cn * 16) = *(const u32x4*)(RVp + (lrow0 + row) * 2048 + h * 512 + cn * 8);
        }
        const bf16_t* qp = RQp + rfrag(h, (int)(lrow0 >> 5) + it, 0, r, hh);
        const float l2g = ret_log2g(h, dir);
        bf16x8 pf[4][2];
#pragma unroll
        for (int jt = 0; jt < 4; ++jt) {
            const bool need = dir == 0 ? (jt <= it) : (jt >= it);
            if (need) {
                f32x16 sa;
#pragma unroll
                for (int e = 0; e < 16; ++e) sa[e] = 0.f;
                const bf16_t* kp = RQp + rfrag(4 + h, (int)(lrow0 >> 5) + jt, 0, r, hh);
#pragma unroll 8
                for (int s = 0; s < 16; ++s) {
                    const bf16x8 kf = *(const bf16x8*)(kp + 512 * s);
                    sa = MFMA32(kf, *(const bf16x8*)(qp + 512 * s), sa);
                }
                const int i = it * 32 + r;
#pragma unroll
                for (int e = 0; e < 16; ++e) {
                    const int j = jt * 32 + crow(e, hh); const int diff = dir == 0 ? i - j : j - i;
                    sa[e] = diff >= 0 ? sa[e] * exp2f((float)diff * l2g) : 0.f;
                }
                pf[jt][0] = pack8(sa, 0); pf[jt][1] = pack8(sa, 1);
            } else { pf[jt][0] = (bf16x8){0, 0, 0, 0, 0, 0, 0, 0}; pf[jt][1] = pf[jt][0]; }
        }
        __syncthreads();
        bf16_t* Y = (dir ? YB : YF) + (lrow0 + it * 32 + r) * 2048 + h * 512;
#pragma unroll 1
        for (int vt = 0; vt < 16; ++vt) {
            f32x16 acc;
#pragma unroll
            for (int e = 0; e < 16; ++e) acc[e] = 0.f;
#pragma unroll
            for (int jt = 0; jt < 4; ++jt) {
                const bool need = dir == 0 ? (jt <= it) : (jt >= it);
                if (need) {
#pragma unroll
                    for (int s2 = 0; s2 < 2; ++s2) {
                        const LAS unsigned char* vp = lds + (jt * 32 + 16 * s2 + 4 * hh + q4) * RI_PITCH + (vt * 32 + 16 * blk) * 2 + 8 * p4;
                        acc = MFMA32(cat8(trd(vp), trd(vp + 8 * RI_PITCH)), pf[jt][s2], acc);
                    }
                }
            }
#pragma unroll
            for (int g4 = 0; g4 < 4; ++g4) {
                u32x2 w; w.x = pk2(acc[4 * g4], acc[4 * g4 + 1]); w.y = pk2(acc[4 * g4 + 2], acc[4 * g4 + 3]);
                *(u32x2*)(Y + vt * 32 + 8 * g4 + 4 * hh) = w;
            }
        }
    }
}

#define XB_TMO      128
#define XB_XCNT(j)  (256  + 64 * (j))
#define XB_XSUB(j)  (1280 + 64 * (j))
#define XB_XGEN(j)  (2304 + 64 * (j))
#define XB_TOP      3328
#define XB_TOPGEN   3392
#define XCD_BAR_WORDS 3456
#define XB_SPIN_CAP (1u << 18)
DI unsigned xb_ld(unsigned* p)              { return __hip_atomic_load(p, __ATOMIC_RELAXED, __HIP_MEMORY_SCOPE_AGENT); }
DI unsigned xb_add(unsigned* p, unsigned v) { return __hip_atomic_fetch_add(p, v, __ATOMIC_RELAXED, __HIP_MEMORY_SCOPE_AGENT); }
DI unsigned xb_xcc_id() { return (unsigned)__builtin_amdgcn_s_getreg((3 << 11) | 20) & 0xFu; }
#define XB_SPIN(cond, bar) do { unsigned _sp = 0; while (cond) { __builtin_amdgcn_s_sleep(1); \
    if ((++_sp & 255u) == 0u) { if (xb_ld(&(bar)[XB_TMO])) break; if (_sp > XB_SPIN_CAP) { atomicAdd(&(bar)[XB_TMO], 1u); break; } } } } while (0)
struct XcdBarrier { unsigned* bar; unsigned x; volatile LAS unsigned* st; };
DI XcdBarrier xcd_barrier_post(unsigned* bar, volatile LAS unsigned* st) {
    XcdBarrier b; b.bar = bar; b.x = xb_xcc_id(); b.st = st;
    if (threadIdx.x == 0) (void)xb_add(&bar[XB_XCNT(b.x)], 1u);
    return b;
}
DI void xcd_barrier_complete(unsigned* bar, unsigned x, unsigned& nloc, unsigned& nx) {
    const unsigned G = gridDim.x * gridDim.y * gridDim.z;
    unsigned sum, cnt, mine, sp = 0u;
    for (;;) {
        sum = 0u; cnt = 0u; mine = 0u;
#pragma unroll
        for (unsigned j = 0; j < 16; ++j) { const unsigned c = xb_ld(&bar[XB_XCNT(j)]); sum += c; cnt += (c > 0u) ? 1u : 0u; mine = (j == x) ? c : mine; }
        if (sum == G) break;
        __builtin_amdgcn_s_sleep(1);
        if ((++sp & 255u) == 0u) { if (xb_ld(&bar[XB_TMO])) break; if (sp > XB_SPIN_CAP) { atomicAdd(&bar[XB_TMO], 1u); break; } }
    }
    nloc = mine > 0u ? mine : 1u; nx = cnt > 0u ? cnt : 1u;
}
DI void xcd_barrier(const XcdBarrier& b) {
    asm volatile("s_waitcnt vmcnt(0)" ::: "memory");
    __syncthreads();
    if (threadIdx.x == 0) {
        unsigned* bar = b.bar;
        __builtin_amdgcn_s_waitcnt(0);
        unsigned nloc = b.st[0], nx = b.st[1];
        if (nloc == 0u) { xcd_barrier_complete(bar, b.x, nloc, nx); b.st[0] = nloc; b.st[1] = nx; }
        const unsigned old = xb_add(&bar[XB_XSUB(b.x)], 1u);
        const unsigned gen = old / nloc;
        if (old + 1u == (gen + 1u) * nloc) {
            __builtin_amdgcn_fence(__ATOMIC_RELEASE, "agent");
            asm volatile("s_waitcnt vmcnt(0)" ::: "memory");
            const unsigned og = xb_add(&bar[XB_TOP], 1u);
            const unsigned tg = og / nx;
            if (og + 1u == (tg + 1u) * nx) xb_add(&bar[XB_TOPGEN], 1u);
            else XB_SPIN(xb_ld(&bar[XB_TOPGEN]) == tg, bar);
            __builtin_amdgcn_fence(__ATOMIC_ACQUIRE, "agent");
            xb_add(&bar[XB_XGEN(b.x)], 1u);
            asm volatile("s_waitcnt vmcnt(0)" ::: "memory");
        } else {
            XB_SPIN(xb_ld(&bar[XB_XGEN(b.x)]) == gen, bar);
            __builtin_amdgcn_fence(__ATOMIC_ACQUIRE, "agent");
            asm volatile("s_waitcnt vmcnt(0)" ::: "memory");
        }
    }
    __syncthreads();
}

constexpr int RS_KS = 0, RS_KP = 528, RS_VS = 128 * 528, RS_VP = 192, RS_ST = RS_VS + 128 * 192, RS_SP = 528;
DI size_t rs_row0(int step, int dir, int b4) {
    const int ch = dir == 0 ? (step < 2 ? 64 + step : step - 2) : 65 - step;
    return ch < 64 ? (size_t)(b4 * SEQ + ch * 128) : (size_t)(4 * SEQ + b4 * CTXL + (ch - 64) * 128);
}
DI void ret_scan_phase(LAS unsigned char* lds, const bf16_t* RQp, const bf16_t* RVp, bf16_t* YF, bf16_t* YB, float* SS, unsigned* ctl, int cid, int G, int bid, int wid0) {
    const int tid = opaque_tid(wid0), lane = tid & 63, wid = __builtin_amdgcn_readfirstlane(tid >> 6);
    const int r = lane & 31, hh = lane >> 5, i16 = lane & 15, q4 = i16 >> 2, p4 = i16 & 3, blk = (lane >> 4) & 1;
    const int c16 = lane & 15, rq = lane >> 4;
    for (int item0 = bid; item0 < 256; item0 += G) {
        int item = item0;
        if (G == 256) {
            volatile LAS unsigned* bw = (volatile LAS unsigned*)(lds + LDS_BYTES - 16);
            __syncthreads();
            if (tid == 0) {
                bool dyn = true;
#pragma unroll
                for (int j = 0; j < 16; ++j) { const unsigned c = xb_ld(&ctl[XB_XCNT(j)]); dyn = dyn && (c == (j < 8 ? 32u : 0u)); }
                unsigned it;
                if (dyn) { const unsigned x = xb_xcc_id(); const unsigned idx = xb_add(&ctl[4096 + (cid * 16 + x) * 64], 1u); it = (x < 8u && idx < 32u) ? x * 32u + idx : 0xffffffffu; }
                else { const int xcd = item0 & 7, idx = item0 >> 3; it = (unsigned)(((xcd * 4 + (idx >> 3)) << 3) | (idx & 7)); }
                bw[2] = it;
            }
            __syncthreads();
            item = (int)bw[2];
            if (item < 0) item = item0;
        }
        const int sl = item & 7, dir = (item >> 3) & 1, h = (item >> 4) & 3, b4 = item >> 6;
        bf16_t* Y = dir ? YB : YF;
        const float l2g = ret_log2g(h, dir);
        f32x16 S[2];
#pragma unroll
        for (int e = 0; e < 16; ++e) { S[0][e] = 0.f; S[1][e] = 0.f; }
        __syncthreads();
        for (int i = tid; i < 64 * RS_SP / 4; i += 512) *(LAS unsigned*)(lds + RS_ST + 4 * i) = 0u;
        const float cdec = exp2f(l2g * 128.0f);
        const int vrow = tid >> 3, vc16 = tid & 7;
        const int kldso = RS_KS + ((tid >> 1) & 31) * RS_KP + (16 * ((tid >> 6) & 7) + 8 * (tid & 1)) * 2;
        const int itok = 16 * wid + c16;
        const float qd = exp2f(l2g * (float)(dir ? 128 - itok : itok + 1));
        const float fi = exp2f(l2g * (float)(dir ? -itok : itok - 127));
        u32x4 kreg[8], vreg[2]; bf16x8 qn[8];
#define RS_LOAD(step_) do { const size_t l_ = rs_row0((step_), dir, b4); \
            _Pragma("unroll") for (int i_ = 0; i_ < 8; ++i_) kreg[i_] = *(const u32x4*)(RQp + rfrag(4 + h, (int)(l_ >> 5), 0, 0, 0) + (size_t)(tid + 512 * i_) * 8); \
            _Pragma("unroll") for (int i_ = 0; i_ < 2; ++i_) vreg[i_] = *(const u32x4*)(RVp + (l_ + vrow + 64 * i_) * 2048 + h * 512 + sl * 64 + vc16 * 8); \
            { const bf16_t* qp_ = RQp + rfrag(h, (int)(l_ >> 5) + (wid >> 1), rq >> 1, 16 * (wid & 1) + c16, rq & 1); \
              _Pragma("unroll") for (int s_ = 0; s_ < 8; ++s_) qn[s_] = *(const bf16x8*)(qp_ + 1024 * s_); } } while (0)
        RS_LOAD(0);
#pragma unroll 1
        for (int step = 0; step < 66; ++step) {
            const size_t lrow0 = rs_row0(step, dir, b4);
#pragma unroll
            for (int i = 0; i < 8; ++i) *(LAS u32x4*)(lds + kldso + (i >> 1) * 32 * RS_KP + (i & 1) * 256) = kreg[i];
#pragma unroll
            for (int i = 0; i < 2; ++i) {
                const int row = vrow + 64 * i; const u32x4 w = vreg[i];
                const float kd = exp2f(l2g * (float)(dir ? row : 127 - row));
                u32x4 o; o.x = pk2(bflo(w.x) * kd, bfhi(w.x) * kd); o.y = pk2(bflo(w.y) * kd, bfhi(w.y) * kd); o.z = pk2(bflo(w.z) * kd, bfhi(w.z) * kd); o.w = pk2(bflo(w.w) * kd, bfhi(w.w) * kd);
                *(LAS u32x4*)(lds + RS_VS + row * RS_VP + vc16 * 16) = o;
            }
            bf16x8 qf[8];
#pragma unroll
            for (int s = 0; s < 8; ++s) qf[s] = qn[s];
            if (step + 1 < 66) RS_LOAD(step + 1);
            LDS_BARRIER();
            if (wid < 4) {
            {
#pragma unroll
                for (int e = 0; e < 16; ++e) { S[0][e] *= cdec; S[1][e] *= cdec; }
#pragma unroll
                for (int s = 0; s < 8; ++s) {
                    const LAS unsigned char* kp = lds + RS_KS + (16 * s + 8 * hh + q4) * RS_KP + (wid * 32 + 16 * blk) * 2 + 8 * p4;
                    const bf16x8 ka = cat8(trd(kp), trd(kp + 4 * RS_KP));
#pragma unroll
                    for (int vt = 0; vt < 2; ++vt) {
                        const LAS unsigned char* vp = lds + RS_VS + (16 * s + 8 * hh + q4) * RS_VP + (vt * 32 + 16 * blk) * 2 + 8 * p4;
                        S[vt] = MFMA32(ka, cat8(trd(vp), trd(vp + 4 * RS_VP)), S[vt]);
                    }
                }
            }
            {
                f32x4 acc[4];
#pragma unroll
                for (int t = 0; t < 4; ++t) acc[t] = (f32x4){0.f, 0.f, 0.f, 0.f};
                const LAS unsigned char* sp = lds + RS_ST + c16 * RS_SP + 16 * rq;
#pragma unroll
                for (int s = 0; s < 8; ++s)
#pragma unroll
                    for (int t = 0; t < 4; ++t) acc[t] = __builtin_amdgcn_mfma_f32_16x16x32_bf16(*(const LAS bf16x8*)(sp + t * 16 * RS_SP + 64 * s), qf[s], acc[t], 0, 0, 0);
#pragma unroll
                for (int t = 0; t < 4; ++t) acc[t] = acc[t] * qd;
#pragma unroll
                for (int p = 0; p < 4; ++p) {
                    const bool need = dir == 0 ? (2 * p <= wid) : (2 * p + 1 >= wid);
                    if (need) {
                        f32x4 sc0 = (f32x4){0.f, 0.f, 0.f, 0.f}, sc1 = (f32x4){0.f, 0.f, 0.f, 0.f};
                        const LAS unsigned char* kq0 = lds + RS_KS + (32 * p + c16) * RS_KP + 16 * rq;
#pragma unroll
                        for (int s = 0; s < 8; ++s) {
                            sc0 = __builtin_amdgcn_mfma_f32_16x16x32_bf16(*(const LAS bf16x8*)(kq0 + 64 * s), qf[s], sc0, 0, 0, 0);
                            sc1 = __builtin_amdgcn_mfma_f32_16x16x32_bf16(*(const LAS bf16x8*)(kq0 + 16 * RS_KP + 64 * s), qf[s], sc1, 0, 0, 0);
                        }
                        float v0[4], v1[4];
#pragma unroll
                        for (int e = 0; e < 4; ++e) {
                            const int j0 = 32 * p + 4 * rq + e, j1 = j0 + 16;
                            const bool k0 = dir == 0 ? (j0 <= itok) : (j0 >= itok), k1 = dir == 0 ? (j1 <= itok) : (j1 >= itok);
                            v0[e] = k0 ? sc0[e] * fi : 0.f; v1[e] = k1 ? sc1[e] * fi : 0.f;
                        }
                        u32x4 pw; pw.x = pk2(v0[0], v0[1]); pw.y = pk2(v0[2], v0[3]); pw.z = pk2(v1[0], v1[1]); pw.w = pk2(v1[2], v1[3]);
                        const bf16x8 pb = __builtin_bit_cast(bf16x8, pw);
#pragma unroll
                        for (int t = 0; t < 4; ++t) {
                            const LAS unsigned char* vp = lds + RS_VS + (32 * p + 4 * rq + (c16 >> 2)) * RS_VP + (16 * t) * 2 + 8 * (c16 & 3);
                            acc[t] = __builtin_amdgcn_mfma_f32_16x16x32_bf16(cat8(trd(vp), trd(vp + 16 * RS_VP)), pb, acc[t], 0, 0, 0);
                        }
                    }
                }
                bf16_t* yp = Y + (lrow0 + itok) * 2048 + h * 512 + sl * 64 + 4 * rq;
                float ssq = 0.f;
#pragma unroll
                for (int t = 0; t < 4; ++t) {
                    const float y0 = acc[t][0], y1 = acc[t][1], y2 = acc[t][2], y3 = acc[t][3];
                    ssq += (y0 * y0 + y1 * y1) + (y2 * y2 + y3 * y3);
                    u32x2 w; w.x = pk2(y0, y1); w.y = pk2(y2, y3);
                    *(u32x2*)(yp + 16 * t) = w;
                }
                ssq += shx(ssq, 16, lane); ssq += shx(ssq, 32, lane);
                if (rq == 0) unsafeAtomicAdd(SS + ((lrow0 + itok) * 4 + h) * 2 + dir, ssq);
            }
            } else {
            {
                f32x4 acc[4];
#pragma unroll
                for (int t = 0; t < 4; ++t) acc[t] = (f32x4){0.f, 0.f, 0.f, 0.f};
                const LAS unsigned char* sp = lds + RS_ST + c16 * RS_SP + 16 * rq;
#pragma unroll
                for (int s = 0; s < 8; ++s)
#pragma unroll
                    for (int t = 0; t < 4; ++t) acc[t] = __builtin_amdgcn_mfma_f32_16x16x32_bf16(*(const LAS bf16x8*)(sp + t * 16 * RS_SP + 64 * s), qf[s], acc[t], 0, 0, 0);
#pragma unroll
                for (int t = 0; t < 4; ++t) acc[t] = acc[t] * qd;
#pragma unroll
                for (int p = 0; p < 4; ++p) {
                    const bool need = dir == 0 ? (2 * p <= wid) : (2 * p + 1 >= wid);
                    if (need) {
                        f32x4 sc0 = (f32x4){0.f, 0.f, 0.f, 0.f}, sc1 = (f32x4){0.f, 0.f, 0.f, 0.f};
                        const LAS unsigned char* kq0 = lds + RS_KS + (32 * p + c16) * RS_KP + 16 * rq;
#pragma unroll
                        for (int s = 0; s < 8; ++s) {
                            sc0 = __builtin_amdgcn_mfma_f32_16x16x32_bf16(*(const LAS bf16x8*)(kq0 + 64 * s), qf[s], sc0, 0, 0, 0);
                            sc1 = __builtin_amdgcn_mfma_f32_16x16x32_bf16(*(const LAS bf16x8*)(kq0 + 16 * RS_KP + 64 * s), qf[s], sc1, 0, 0, 0);
                        }
                        float v0[4], v1[4];
#pragma unroll
                        for (int e = 0; e < 4; ++e) {
                            const int j0 = 32 * p + 4 * rq + e, j1 = j0 + 16;
                            const bool k0 = dir == 0 ? (j0 <= itok) : (j0 >= itok), k1 = dir == 0 ? (j1 <= itok) : (j1 >= itok);
                            v0[e] = k0 ? sc0[e] * fi : 0.f; v1[e] = k1 ? sc1[e] * fi : 0.f;
                        }
                        u32x4 pw; pw.x = pk2(v0[0], v0[1]); pw.y = pk2(v0[2], v0[3]); pw.z = pk2(v1[0], v1[1]); pw.w = pk2(v1[2], v1[3]);
                        const bf16x8 pb = __builtin_bit_cast(bf16x8, pw);
#pragma unroll
                        for (int t = 0; t < 4; ++t) {
                            const LAS unsigned char* vp = lds + RS_VS + (32 * p + 4 * rq + (c16 >> 2)) * RS_VP + (16 * t) * 2 + 8 * (c16 & 3);
                            acc[t] = __builtin_amdgcn_mfma_f32_16x16x32_bf16(cat8(trd(vp), trd(vp + 16 * RS_VP)), pb, acc[t], 0, 0, 0);
                        }
                    }
                }
                bf16_t* yp = Y + (lrow0 + itok) * 2048 + h * 512 + sl * 64 + 4 * rq;
                float ssq = 0.f;
#pragma unroll
                for (int t = 0; t < 4; ++t) {
                    const float y0 = acc[t][0], y1 = acc[t][1], y2 = acc[t][2], y3 = acc[t][3];
                    ssq += (y0 * y0 + y1 * y1) + (y2 * y2 + y3 * y3);
                    u32x2 w; w.x = pk2(y0, y1); w.y = pk2(y2, y3);
                    *(u32x2*)(yp + 16 * t) = w;
                }
                ssq += shx(ssq, 16, lane); ssq += shx(ssq, 32, lane);
                if (rq == 0) unsafeAtomicAdd(SS + ((lrow0 + itok) * 4 + h) * 2 + dir, ssq);
            }
            {
#pragma unroll
                for (int e = 0; e < 16; ++e) { S[0][e] *= cdec; S[1][e] *= cdec; }
#pragma unroll
                for (int s = 0; s < 8; ++s) {
                    const LAS unsigned char* kp = lds + RS_KS + (16 * s + 8 * hh + q4) * RS_KP + (wid * 32 + 16 * blk) * 2 + 8 * p4;
                    const bf16x8 ka = cat8(trd(kp), trd(kp + 4 * RS_KP));
#pragma unroll
                    for (int vt = 0; vt < 2; ++vt) {
                        const LAS unsigned char* vp = lds + RS_VS + (16 * s + 8 * hh + q4) * RS_VP + (vt * 32 + 16 * blk) * 2 + 8 * p4;
                        S[vt] = MFMA32(ka, cat8(trd(vp), trd(vp + 4 * RS_VP)), S[vt]);
                    }
                }
            }
            }
            LDS_BARRIER();
#pragma unroll
            for (int vt = 0; vt < 2; ++vt)
#pragma unroll
                for (int g4 = 0; g4 < 4; ++g4) {
                    u32x2 w; w.x = pk2(S[vt][4 * g4], S[vt][4 * g4 + 1]); w.y = pk2(S[vt][4 * g4 + 2], S[vt][4 * g4 + 3]);
                    *(LAS u32x2*)(lds + RS_ST + (vt * 32 + r) * RS_SP + (wid * 32 + 8 * g4 + 4 * hh) * 2) = w;
                }
        }
#undef RS_LOAD
    }
}

#define REP_PRO 1
#define REP_NORM 1
#define REP_GQKV 1
#define REP_ATTN 1
#define REP_GRQKV 1
#define REP_RIRS 1
#define REP_RI 1
#define REP_GGU 1
#define REP_SYNC 0
#define REP_GDOWN 0
#define REP_GWO 0
#define REP_GGATE 1
#define REP_GRWO 0
#define REPEAT(n) _Pragma("unroll 1") for (int rep_ = 0; rep_ < (n); ++rep_)
#define REPEAT2(n) _Pragma("unroll 1") for (int rep2_ = 0; rep2_ < (n); ++rep2_)
__global__ void __launch_bounds__(512) fwd_megakernel(Params P) {
    extern __shared__ __attribute__((aligned(16))) unsigned char lds_raw[];
    LAS unsigned char* lds = (LAS unsigned char*)lds_raw;
    cg::grid_group grid = cg::this_grid();
    const int G = gridDim.x, bid = blockIdx.x;
    const int wid0 = __builtin_amdgcn_readfirstlane(threadIdx.x >> 6);
    volatile LAS unsigned* bst = (volatile LAS unsigned*)(lds + LDS_BYTES - 16);
    if (threadIdx.x < 4) bst[threadIdx.x] = 0u;
    __syncthreads();
    const XcdBarrier xbar = xcd_barrier_post((unsigned*)(P.ws + WS_CTL), bst);
#define GSYNC() xcd_barrier(xbar)
    unsigned char* ws = P.ws;
#define MOD ((float*)(ws + WS_MOD))
#define ROPEA_C ((float*)(ws + WS_ROPEA))
#define ROPEA_S (ROPEA_C + SEQ * 32)
#define ROPER_C ((float*)(ws + WS_ROPER))
#define ROPER_S (ROPER_C + SEQ * 128)
#define XB ((bf16_t*)(ws + WS_XB))
#define SS ((float*)(ws + WS_SS))
#define WQKV ((bf16_t*)(ws + WS_WQKV))
#define WAO ((bf16_t*)(ws + WS_WAO))
#define WP ((bf16_t*)(ws + WS_WP))
#define WIN ((bf16_t*)(ws + WS_WIN))
#define WRO ((bf16_t*)(ws + WS_WRO))
#define WGU ((bf16_t*)(ws + WS_WGU))
#define WD ((bf16_t*)(ws + WS_WD))
#define H ((bf16_t*)(ws + WS_H))
#define QKV ((bf16_t*)(ws + WS_QKV))
#define AO ((bf16_t*)(ws + WS_AO))
#define HID ((bf16_t*)(ws + WS_HID))
#define POOLED ((bf16_t*)(ws + WS_POOLED))
#define RQ ((bf16_t*)(ws + WS_RQKV))
#define RV ((bf16_t*)(ws + WS_RQKV + 132 * MiB))
#define YF ((bf16_t*)(ws + WS_YF))
#define YB ((bf16_t*)(ws + WS_YB))
#define Z ((bf16_t*)(ws + WS_Z))
    REPEAT(REP_PRO) {
        const int tid = opaque_tid(wid0), lane = tid & 63, wid = __builtin_amdgcn_readfirstlane(tid >> 6);
        const int gw = bid * 8 + wid, NGW = G * 8, gtid = bid * 512 + tid, NT = G * 512;
        LAS float* sc = (LAS float*)lds;
        LAS float* part = (LAS float*)(lds + 36864);
        for (int blk = bid; blk < 192; blk += G) {
            __syncthreads();
            for (int i = tid; i < 9 * DM; i += 512) { const int bb = i >> 10, k = i & 1023; const float v = bb < 8 ? P.c[bb * DM + k] : P.c_ctx[k]; sc[i] = silu_f(v); }
            __syncthreads();
            const int col = tid & 127, kq = tid >> 7;
            const int idx = blk * 128 + col, l = idx / MODW, n = idx % MODW;
            const float* w = P.ada_w + (size_t)l * DM * MODW + n + (size_t)(kq * 256) * MODW;
            float a[9];
#pragma unroll
            for (int bb = 0; bb < 9; ++bb) a[bb] = 0.f;
#pragma unroll 8
            for (int k = 0; k < 256; ++k) {
                const float wv = w[(size_t)k * MODW];
#pragma unroll
                for (int bb = 0; bb < 9; ++bb) a[bb] += sc[bb * DM + kq * 256 + k] * wv;
            }
#pragma unroll
            for (int bb = 0; bb < 9; ++bb) part[(kq * 9 + bb) * 128 + col] = a[bb];
            __syncthreads();
            if (kq == 0) {
                const float bv = P.ada_b[l * MODW + n];
#pragma unroll
                for (int bb = 0; bb < 9; ++bb) MOD[(l * 9 + bb) * MODW + n] = ((part[bb * 128 + col] + part[(9 + bb) * 128 + col]) + (part[(18 + bb) * 128 + col] + part[(27 + bb) * 128 + col])) + bv;
            }
        }
        __syncthreads();
        if (REP_GDOWN + REP_GWO + REP_GRWO > 0) for (int i = gtid; i < 9 * MODW; i += NT) ((float*)(ws + WS_ZERO))[i] = 0.f;
        for (int i = gtid; i < SEQ * 32; i += NT) {
            const int t = i >> 5, j = i & 31; const float pos = (float)(j < 16 ? (t >> 6) : (t & 63));
            const float inv = powf(10000.0f, -(float)(j & 15) / 16.0f); const float ang = pos * inv;
            ROPEA_C[i] = cosf(ang); ROPEA_S[i] = sinf(ang);
        }
        for (int i = gtid; i < SEQ * 128; i += NT) {
            const int t = i >> 7, j = i & 127;
            const float inv = powf(10000.0f, -((float)j / 127.0f)); const float ang = (float)t * inv;
            ROPER_C[i] = cosf(ang); ROPER_S[i] = sinf(ang);
        }
        LAS float* scr = (LAS float*)(lds + 57344 + wid * 8704);
        int cnt = 0;
        for (int s = 0; s < 2; ++s) {
            transpose_matrix(P.attn_w_qkv + (size_t)s * DM * 1536, DM, 1536, 0, 1536, WQKV + (size_t)s * 1536 * DM, DM, 0, 1, scr, lane, gw, NGW, cnt);
            transpose_matrix(P.attn_w_o + (size_t)s * DM * DM, DM, DM, 0, DM, WAO + (size_t)s * DM * DM, DM, 0, 0, scr, lane, gw, NGW, cnt);
        }
        for (int g = 0; g < 4; ++g) transpose_matrix(P.pool_w + (size_t)g * 256 * 256, 256, 256, 0, 256, WP, 256, g * 256, 0, scr, lane, gw, NGW, cnt);
        transpose_matrix(P.ret_w_in, DM, 8192, 0, 4096, WIN, DM, 0, 0, scr, lane, gw, NGW, cnt);
        transpose_matrix(P.ret_w_in, DM, 8192, 4096, 2048, WIN, DM, 4096, 2, scr, lane, gw, NGW, cnt);
        transpose_matrix(P.ret_w_in, DM, 8192, 6144, 2048, WIN, DM, 4096, 3, scr, lane, gw, NGW, cnt);
        transpose_matrix(P.ret_w_o, 2048, DM, 0, DM, WRO, 2048, 0, 0, scr, lane, gw, NGW, cnt);
        for (int l = 0; l < 4; ++l) {
            transpose_matrix(P.ffn_w_gate + (size_t)l * DM * FFH, DM, FFH, 0, FFH, WGU + (size_t)l * 5632 * DM, DM, 0, 2, scr, lane, gw, NGW, cnt);
            transpose_matrix(P.ffn_w_up + (size_t)l * DM * FFH, DM, FFH, 0, FFH, WGU + (size_t)l * 5632 * DM, DM, 0, 3, scr, lane, gw, NGW, cnt);
            transpose_matrix(P.ffn_w_down + (size_t)l * FFH * DM, FFH, DM, 0, DM, WD + (size_t)l * DM * FFH, FFH, 0, 0, scr, lane, gw, NGW, cnt);
        }
        grid.sync();
    }

#pragma unroll 1
    for (int layer = 0; layer < 4; ++layer) {
        const int kind = layer % 3, slot = layer / 3;
        const float* modl = MOD + (size_t)layer * 9 * MODW;
        const int ntm = layer < 3 ? NTILE_M : 256;
        if (layer == 0) { prenorm_phase<true>(P.x, P.ctx, XB, P.norm_mix + layer * DM, modl, 0, 1, H, 0, MTOT, G, bid, wid0); GSYNC(); }
        if (kind == 0) {
            REPEAT(REP_GQKV) {
                pg8::Gemm g{H, WQKV + (size_t)slot * 1536 * DM, DM, DM, DM, 0, 0}; pg8::Sched S; S.init(NTILE_M, 6, G, bid, NTILE_M, 0, 0);
                pg8::EpiAttnQKV E{QKV, P.attn_q_norm + slot * 64, P.attn_k_norm + slot * 64, ROPEA_C, ROPEA_S};
                pg8::gemm_phase(lds, g, S, E, wid0);
                GSYNC();
            }
            REPEAT(REP_ATTN) { attn_phase(lds, QKV, AO, P.attn_sink + slot * 16, layer < 3, G, bid, wid0); GSYNC(); }
            {
                pg8::Gemm g{AO, WAO + (size_t)slot * DM * DM, DM, DM, DM, 0, 0}; pg8::Sched S; S.init(256, 4, G, bid, 256, 0, 0);
                if (layer == 0) { pg8::EpiResid<true, false> E{P.x, P.ctx, XB, P.out, modl + 2 * DM, nullptr}; pg8::gemm_phase(lds, g, S, E, wid0); }
                else { pg8::EpiResid<false, false> E{P.x, P.ctx, XB, P.out, modl + 2 * DM, nullptr}; pg8::gemm_phase(lds, g, S, E, wid0); }
            }
        } else if (kind == 1) {
            REPEAT(REP_NORM) { pool_phase(H, POOLED, G, bid, wid0); GSYNC(); }
            {
                pg8::Gemm g{POOLED, WP, DM, 256, 256, 0, 1}; pg8::Sched S; S.init(256, 4, G, bid, 256, 0, 0);
                pg8::EpiResid<false, false> E{P.x, P.ctx, XB, P.out, modl + 2 * DM, P.pool_scale + slot * DM};
                pg8::gemm_phase(lds, g, S, E, wid0);
            }
        } else {
#pragma unroll 1
            for (int hb = 0; hb < 2; ++hb) {
                const int s0b = hb * 128, s1b = 256 + hb * 4;
                REPEAT(REP_GRQKV) {
                    pg8::Gemm g{H, WIN, DM, DM, DM, 0, 0}; pg8::Sched S; S.init(132, 16, G, bid, 128, s0b, s1b);
                    pg8::EpiRetQKV E{RQ, RV, ROPER_C, ROPER_S, SS};
                    pg8::gemm_phase(lds, g, S, E, wid0);
                    GSYNC();
                }
                {
                    ret_scan_phase(lds, RQ, RV, YF, YB, SS, (unsigned*)(ws + WS_CTL), hb, G, bid, wid0);
                    GSYNC();
                }
                REPEAT(REP_GGATE) {
                    pg8::Gemm g{H, WIN + (size_t)4096 * DM, DM, DM, DM, 0, 0}; pg8::Sched S; S.init(132, 16, G, bid, 128, s0b, s1b);
                    pg8::EpiRetGate E{YF, YB, SS, Z};
                    pg8::gemm_phase(lds, g, S, E, wid0);
                    GSYNC();
                }
                {
                    pg8::Gemm g{Z, WRO, 2048, 2048, 2048, 1, 0}; pg8::Sched S; S.init(132, 4, G, bid, 128, s0b, s1b);
                    pg8::EpiResid<false, false> E{P.x, P.ctx, XB, P.out, modl + 2 * DM, nullptr};
                    pg8::gemm_phase(lds, g, S, E, wid0);
                }
                if (hb == 0) GSYNC();
            }
        }
        GSYNC();
        if (kind != 2 && layer < 3) {
            const int nbc = G >= 64 ? 32 : G / 2;
            if (bid < nbc) {
                pg8::Sched S2; S2.init(8, 4, nbc, bid, 0, 0, 256);
                if (kind == 0) {
                    pg8::Gemm g{AO, WAO + (size_t)slot * DM * DM, DM, DM, DM, 0, 0};
                    if (layer == 0) { pg8::EpiResid<true, false> E{P.x, P.ctx, XB, P.out, modl + 2 * DM, nullptr}; pg8::gemm_phase(lds, g, S2, E, wid0); }
                    else { pg8::EpiResid<false, false> E{P.x, P.ctx, XB, P.out, modl + 2 * DM, nullptr}; pg8::gemm_phase(lds, g, S2, E, wid0); }
                } else {
                    pg8::Gemm g{POOLED, WP, DM, 256, 256, 0, 1};
                    pg8::EpiResid<false, false> E{P.x, P.ctx, XB, P.out, modl + 2 * DM, P.pool_scale + slot * DM}; pg8::gemm_phase(lds, g, S2, E, wid0);
                }
            } else prenorm_phase<false>(P.x, P.ctx, XB, P.norm_ffn + layer * DM, modl, 3, 4, H, 0, MLAT, G - nbc, bid - nbc, wid0);
            GSYNC();
            prenorm_phase<false>(P.x, P.ctx, XB, P.norm_ffn + layer * DM, modl, 3, 4, H, MLAT, MTOT, G, bid, wid0); GSYNC();
        } else { prenorm_phase<false>(P.x, P.ctx, XB, P.norm_ffn + layer * DM, modl, 3, 4, H, 0, ntm * 256, G, bid, wid0); GSYNC(); }
        REPEAT(REP_GGU) {
            pg8::Gemm g{H, WGU + (size_t)layer * 5632 * DM, DM, DM, DM, 0, 0}; pg8::Sched S; S.init(ntm, 22, G, bid, ntm, 0, 0);
            pg8::EpiSwiGLU E{HID};
            pg8::gemm_phase(lds, g, S, E, wid0);
            GSYNC();
        }
        {
            pg8::Gemm g{HID, WD + (size_t)layer * DM * FFH, FFH, FFH, FFH, 0, 0};
            if (layer == 3) {
                pg8::Sched S; S.init(256, 4, G, bid, 256, 0, 0);
                pg8::EpiResid<false, true> E{P.x, P.ctx, XB, P.out, modl + 5 * DM, nullptr}; pg8::gemm_phase(lds, g, S, E, wid0);
                GSYNC();
            } else {
                pg8::EpiResid<false, false> E{P.x, P.ctx, XB, P.out, modl + 5 * DM, nullptr};
                { pg8::Sched S; S.init(256, 4, G, bid, 256, 0, 0); pg8::gemm_phase(lds, g, S, E, wid0); }
                GSYNC();
                const int nbc = G >= 64 ? 32 : G / 2;
                const float* modn = modl + 9 * MODW; const float* gn = P.norm_mix + (layer + 1) * DM;
                if (bid < nbc) { pg8::Sched S; S.init(8, 4, nbc, bid, 0, 0, 256); pg8::gemm_phase(lds, g, S, E, wid0); }
                else prenorm_phase<false>(P.x, P.ctx, XB, gn, modn, 0, 1, H, 0, MLAT, G - nbc, bid - nbc, wid0);
                GSYNC();
                prenorm_phase<false>(P.x, P.ctx, XB, gn, modn, 0, 1, H, MLAT, MTOT, G, bid, wid0);
                GSYNC();
            }
        }
        REPEAT(REP_SYNC) GSYNC();
    }
}

extern "C" void kernel_launch(void* const* d_in, const int* in_sizes, int n_in, void* d_out, int out_size, void* d_ws, size_t ws_size, hipStream_t stream) {
    static int grid_blocks = 0;
    if (grid_blocks == 0) {
        if (n_in != 20 || ws_size < WS_END) { fprintf(stderr, "kernel_launch: unexpected inputs (n_in %d, ws %zu)\n", n_in, ws_size); grid_blocks = -1; return; }
        int dev = 0, cus = 0, per_cu = 0;
        hipGetDevice(&dev);
        hipDeviceGetAttribute(&cus, hipDeviceAttributeMultiprocessorCount, dev);
        if (hipFuncSetAttribute((const void*)fwd_megakernel, hipFuncAttributeMaxDynamicSharedMemorySize, LDS_BYTES) != hipSuccess) { fprintf(stderr, "kernel_launch: hipFuncSetAttribute failed\n"); grid_blocks = -1; return; }
        if (hipOccupancyMaxActiveBlocksPerMultiprocessor(&per_cu, (const void*)fwd_megakernel, 512, LDS_BYTES) != hipSuccess || per_cu < 1) { fprintf(stderr, "kernel_launch: occupancy query failed (%d)\n", per_cu); per_cu = 1; (void)hipGetLastError(); }
        grid_blocks = cus * per_cu;
    }
    if (grid_blocks < 0) return;
    Params p{};
    p.x = (const float*)d_in[0]; p.c = (const float*)d_in[1]; p.ctx = (const float*)d_in[2]; p.c_ctx = (const float*)d_in[3]; p.ada_w = (const float*)d_in[4]; p.ada_b = (const float*)d_in[5];
    p.norm_mix = (const float*)d_in[6]; p.norm_ffn = (const float*)d_in[7]; p.attn_w_qkv = (const float*)d_in[8]; p.attn_w_o = (const float*)d_in[9]; p.attn_q_norm = (const float*)d_in[10];
    p.attn_k_norm = (const float*)d_in[11]; p.attn_sink = (const float*)d_in[12]; p.pool_w = (const float*)d_in[13]; p.pool_scale = (const float*)d_in[14]; p.ret_w_in = (const float*)d_in[15];
    p.ret_w_o = (const float*)d_in[16]; p.ffn_w_gate = (const float*)d_in[17]; p.ffn_w_up = (const float*)d_in[18]; p.ffn_w_down = (const float*)d_in[19];
    p.out = (float*)d_out; p.ws = (unsigned char*)d_ws;
    if (hipMemsetAsync((char*)d_ws + WS_CTL, 0, 32768, stream) != hipSuccess) { fprintf(stderr, "kernel_launch: memset failed\n"); return; }
    void* args[] = {&p};
    hipError_t e = hipLaunchCooperativeKernel((const void*)fwd_megakernel, dim3(grid_blocks), dim3(512), args, LDS_BYTES, stream);
    if (e != hipSuccess) fprintf(stderr, "cooperative launch failed: %s (grid %d)\n", hipGetErrorString(e), grid_blocks);
}
```

```cpp
#include <hip/hip_runtime.h>
#include <hip/hip_cooperative_groups.h>
#include <cstdio>
#include <cstdint>
namespace cg = cooperative_groups;

#define DI __device__ __forceinline__
#define LAS __attribute__((address_space(3)))
typedef unsigned short bf16_t;
typedef short bf16x8 __attribute__((ext_vector_type(8)));
typedef short s16x4 __attribute__((ext_vector_type(4)));
typedef float f32x4 __attribute__((ext_vector_type(4)));
typedef float f32x16 __attribute__((ext_vector_type(16)));
typedef unsigned u32x4 __attribute__((ext_vector_type(4)));
typedef unsigned u32x2 __attribute__((ext_vector_type(2)));
typedef float f32x2_t __attribute__((ext_vector_type(2)));
typedef __bf16 bf16x2_t __attribute__((ext_vector_type(2)));
typedef short v4i16_t __attribute__((ext_vector_type(4)));

DI unsigned pk2(float lo, float hi) { f32x2_t v = {lo, hi}; bf16x2_t b = __builtin_convertvector(v, bf16x2_t); return __builtin_bit_cast(unsigned, b); }
DI float bflo(unsigned w) { return __uint_as_float(w << 16); }
DI float bfhi(unsigned w) { return __uint_as_float(w & 0xffff0000u); }
DI float silu_f(float x) { return x * __builtin_amdgcn_rcpf(1.0f + __expf(-x)); }
DI size_t rfrag(int mat, int rowtile, int s, int r, int hh) { return ((((size_t)mat * 1056 + rowtile) * 16 + s) * 64 + r * 2 + hh) * 8; }
DI int crow(int reg, int h) { return (reg & 3) + 8 * (reg >> 2) + 4 * h; }
DI float shx(float v, int m, int lane) { return __int_as_float(__builtin_amdgcn_ds_bpermute((lane ^ m) << 2, __float_as_int(v))); }
DI float wave_sum(float v, int lane) {
#pragma unroll
    for (int o = 1; o < 64; o <<= 1) v += shx(v, o, lane);
    return v;
}
DI int opaque_tid(int wid0) { int l; asm volatile("v_mbcnt_lo_u32_b32 %0, -1, 0\n\tv_mbcnt_hi_u32_b32 %0, -1, %0" : "=v"(l)); return wid0 * 64 + l; }
DI int opq(int v) { asm volatile("" : "+v"(v)); return v; }
#define LDS_BARRIER() do { asm volatile("s_waitcnt lgkmcnt(0)" ::: "memory"); __builtin_amdgcn_s_barrier(); asm volatile("" ::: "memory"); } while (0)
#define MFMA32(a, b, c) __builtin_amdgcn_mfma_f32_32x32x16_bf16((a), (b), (c), 0, 0, 0)
DI s16x4 trd(const LAS unsigned char* p) { return __builtin_bit_cast(s16x4, __builtin_amdgcn_ds_read_tr16_b64_v4i16((LAS v4i16_t*)p)); }
DI bf16x8 cat8(s16x4 lo, s16x4 hi) { return __builtin_shufflevector(lo, hi, 0, 1, 2, 3, 4, 5, 6, 7); }
DI bf16x8 pack8(const f32x16& x, int s) {
    u32x4 p; p.x = pk2(x[8 * s], x[8 * s + 1]); p.y = pk2(x[8 * s + 2], x[8 * s + 3]); p.z = pk2(x[8 * s + 4], x[8 * s + 5]); p.w = pk2(x[8 * s + 6], x[8 * s + 7]);
    return __builtin_bit_cast(bf16x8, p);
}

constexpr int DM = 1024, NB = 8, SEQ = 8192, CTXL = 256, FFH = 2816;
constexpr int MLAT = NB * SEQ, MCTX = NB * CTXL, MTOT = MLAT + MCTX;
constexpr int NTILE_M = MTOT / 256;
constexpr int MODW = 6 * DM;
constexpr int MHALF = 4 * SEQ + 4 * CTXL;
constexpr float NEPS = 1e-6f;

constexpr size_t MiB = 1u << 20;
constexpr size_t WS_MOD = 0;
constexpr size_t WS_CTL = 896 * 1024;
constexpr size_t WS_ROPEA = 1 * MiB;
constexpr size_t WS_ROPER = 3 * MiB;
constexpr size_t WS_XC = 11 * MiB;
constexpr size_t WS_SS = 19 * MiB;
constexpr size_t WS_ZERO = 35 * MiB + 640 * 1024;
constexpr size_t WS_WQKV = 36 * MiB;
constexpr size_t WS_WAO = 42 * MiB;
constexpr size_t WS_WP = 46 * MiB;
constexpr size_t WS_WIN = 47 * MiB;
constexpr size_t WS_WRO = 63 * MiB;
constexpr size_t WS_WGU = 67 * MiB;
constexpr size_t WS_WD = 111 * MiB;
constexpr size_t WS_H = 133 * MiB;
constexpr size_t WS_BIG = 265 * MiB;
constexpr size_t WS_QKV = WS_BIG;
constexpr size_t WS_AO = WS_BIG + 198 * MiB;
constexpr size_t WS_HID = WS_BIG;
constexpr size_t WS_POOLED = WS_BIG;
constexpr size_t WS_RQKV = WS_BIG;
constexpr size_t WS_YF = WS_BIG + 264 * MiB;
constexpr size_t WS_YB = WS_BIG + 396 * MiB;
constexpr size_t WS_Z = WS_BIG;
constexpr size_t WS_XB = WS_BIG + 528 * MiB;
constexpr size_t WS_END = WS_BIG + 660 * MiB;

constexpr int LDS_BYTES = 147456;

namespace pg8 {
constexpr int STAGGER_TICKS = 35;
constexpr int BM = 256, BK = 64, HALF = 128, HTB = HALF * BK * 2, STAGE_BYTES = 8 * HTB, NXCD = 8, WGM = 8;
DI int lds_byte(int r, int c) { const int st = (r >> 4) * 2 + (c >> 5), rr = r & 15, cc = c & 31, ob = rr * 64 + cc * 2; return st * 1024 + (ob ^ (((ob >> 9) & 1) << 5)); }
DI void stage_rc(int b, int& R, int& C) { const int st = b / 1024, sb = b % 1024, swz = sb ^ (((sb >> 9) & 1) << 5); R = (st >> 1) * 16 + swz / 64; C = (st & 1) * 32 + (swz % 64) / 2; }
DI int perm32(int rho) { const int n = rho >> 4, i = rho & 15; return 8 * (i >> 2) + 4 * n + (i & 3); }

struct Unit { int pm, pn, lt; };
struct Gemm { const bf16_t* A; const bf16_t* Bt; int lda, ldb, K; int a_local; int grouped; };

struct Sched {
    int nM, nN, nwg, G, c, s0n, s0b, s1b;
    DI void init(int nM_, int nN_, int G_, int c_, int s0n_, int s0b_, int s1b_) { nM = nM_; nN = nN_; nwg = nM * nN; G = G_; c = c_; s0n = s0n_; s0b = s0b_; s1b = s1b_; }
    DI bool next(int i, Unit& u) const {
        const long L = (long)i * G + c; if (L >= nwg) return false;
        int wgid = (int)L; { const int q = nwg / NXCD, r = nwg % NXCD, xcd = wgid % NXCD, off = wgid / NXCD; wgid = (xcd < r ? xcd * (q + 1) : r * (q + 1) + (xcd - r) * q) + off; }
        const int nig = WGM * nN, gid = wgid / nig, fm = gid * WGM, gsz = (nM - fm) < WGM ? (nM - fm) : WGM;
        const int t = fm + ((wgid % nig) % gsz); u.pn = (wgid % nig) / gsz; u.lt = t; u.pm = t < s0n ? s0b + t : s1b + (t - s0n); return true;
    }
};

template <class Epi>
DI void gemm_phase(LAS unsigned char* lds, const Gemm g, const Sched& S, const Epi& E, int wid0) {
    const int tid = opaque_tid(wid0), wid = __builtin_amdgcn_readfirstlane(tid >> 6), lane = tid & 63, wr = wid >> 2, wc = wid & 3, fr = lane & 15, fq = lane >> 4;
    const int K = g.K, nt = K / BK;
    unsigned voffA[2], voffB[2];
#pragma unroll
    for (int i = 0; i < 2; ++i) { int R, C; stage_rc(tid * 16 + i * 8192, R, C); const int Rb = Epi::PERM ? ((R & ~31) + perm32(R & 31)) : R;
        voffA[i] = (unsigned)(R * g.lda + C) * 2u; voffB[i] = (unsigned)(Rb * g.ldb + C) * 2u; }
    const size_t kstep = (size_t)(BK * 2);
    const size_t hstepA = (size_t)HALF * g.lda * 2, hstepB = (size_t)HALF * g.ldb * 2;
    const size_t tstepA = 2 * hstepA, tstepB = 2 * hstepB;
    const unsigned ldsw = (unsigned)wid * 1024u;
    const int aoff = lds_byte(wr * 64 + fr, fq * 8), boff = lds_byte(wc * 32 + fr, fq * 8);
#define PG8_SA(b, h) (((b) * 2 + (h)) * HTB)
#define PG8_SB(b, h) ((4 + (b) * 2 + (h)) * HTB)
#define PG8_STAGE(bufoff, gbase, voff) do { _Pragma("unroll") for (int _i = 0; _i < 2; ++_i) \
        __builtin_amdgcn_global_load_lds((const unsigned*)((const char*)(gbase) + (voff)[_i]), (LAS unsigned*)(lds + (bufoff) + ldsw + _i * 8192), 16, 0, 0); } while (0)
#define PG8_LDA(dst, b, h) do { _Pragma("unroll") for (int m = 0; m < 4; ++m) _Pragma("unroll") for (int k = 0; k < 2; ++k) dst[m][k] = *(const LAS bf16x8*)(lds + PG8_SA(b, h) + aoff + m * 2048 + k * 1024); } while (0)
#define PG8_LDB(dst, b, h) do { _Pragma("unroll") for (int n = 0; n < 2; ++n) _Pragma("unroll") for (int k = 0; k < 2; ++k) dst[n][k] = *(const LAS bf16x8*)(lds + PG8_SB(b, h) + boff + n * 2048 + k * 1024); } while (0)
#define PG8_MMA(ai, bj, At, Bt) do { __builtin_amdgcn_s_setprio(1); _Pragma("unroll") for (int m = 0; m < 4; ++m) _Pragma("unroll") for (int n = 0; n < 2; ++n) _Pragma("unroll") for (int k = 0; k < 2; ++k) \
        acc[ai][bj][m][n] = __builtin_amdgcn_mfma_f32_16x16x32_bf16(Bt[n][k], At[m][k], acc[ai][bj][m][n], 0, 0, 0); __builtin_amdgcn_s_setprio(0); } while (0)
#define PG8_WAIT_V(n) asm volatile("s_waitcnt vmcnt(" #n ")" ::: "memory")
#define PG8_WAIT_L(n) asm volatile("s_waitcnt lgkmcnt(" #n ")" ::: "memory")
#define PG8_BAR __builtin_amdgcn_s_barrier()
#define PG8_SCHED __builtin_amdgcn_sched_barrier(0)
#define PG8_APTR(u) ((const char*)g.A + (size_t)(g.a_local ? (u).lt : (u).pm) * tstepA + (g.grouped ? (size_t)(u).pn * K * 2 : (size_t)0))
#define PG8_BPTR(u) ((const char*)g.Bt + (size_t)(u).pn * tstepB)
    Unit cur, nxt; int ui = 0;
    if (!S.next(0, cur)) return;
    if (Epi::STAGGER) {
        const int nmine = (S.nwg - S.c + S.G - 1) / S.G, nmax = (S.nwg + S.G - 1) / S.G;
        if (nmine < nmax) {
            const unsigned long long delay = (unsigned long long)(((S.c >> 3) & 3) * nt * STAGGER_TICKS);
            const unsigned long long t0 = __builtin_amdgcn_s_memrealtime();
            while (__builtin_amdgcn_s_memrealtime() - t0 < delay) __builtin_amdgcn_s_sleep(32);
        }
    }
    f32x4 acc[2][2][4][2];
#pragma unroll
    for (int a = 0; a < 2; ++a)
#pragma unroll
        for (int b = 0; b < 2; ++b)
#pragma unroll
            for (int m = 0; m < 4; ++m)
#pragma unroll
                for (int n = 0; n < 2; ++n) acc[a][b][m][n] = (f32x4){0.f, 0.f, 0.f, 0.f};
    bf16x8 At[4][2], B0[2][2], B1[2][2];
    const char* cA = PG8_APTR(cur); const char* cB = PG8_BPTR(cur);
    PG8_STAGE(PG8_SB(0, 0), cB, voffB); PG8_STAGE(PG8_SB(0, 1), cB + hstepB, voffB); PG8_STAGE(PG8_SA(0, 0), cA, voffA); PG8_STAGE(PG8_SA(0, 1), cA + hstepA, voffA);
    if (wr == 1) PG8_BAR;
    PG8_WAIT_V(2); PG8_BAR;
    PG8_STAGE(PG8_SB(1, 0), cB + kstep, voffB); PG8_STAGE(PG8_SA(1, 0), cA + kstep, voffA); PG8_STAGE(PG8_SB(1, 1), cB + hstepB + kstep, voffB);
    PG8_WAIT_V(6); PG8_BAR;
    for (;;) {
        const bool has_next = S.next(ui + 1, nxt);
        const char* nA = has_next ? PG8_APTR(nxt) : cA; const char* nB = has_next ? PG8_BPTR(nxt) : cB;
        for (int t = 0; t < nt; t += 2) {
            const bool last = (t == nt - 2);
            const char* a1 = cA + (size_t)(t + 1) * kstep;
            const char* a2 = last ? nA : cA + (size_t)(t + 2) * kstep; const char* b2 = last ? nB : cB + (size_t)(t + 2) * kstep;
            const char* a3 = a2 + kstep; const char* b3 = b2 + kstep;
            PG8_LDB(B0, 0, 0); PG8_LDB(B1, 0, 1); PG8_SCHED; PG8_LDA(At, 0, 0); PG8_STAGE(PG8_SA(1, 1), a1 + hstepA, voffA);
            PG8_WAIT_V(8); PG8_WAIT_L(0); PG8_BAR; PG8_MMA(0, 0, At, B0); PG8_MMA(0, 1, At, B1); PG8_BAR; PG8_SCHED;
            PG8_LDA(At, 0, 1); PG8_STAGE(PG8_SB(0, 0), b2, voffB); PG8_STAGE(PG8_SB(0, 1), b2 + hstepB, voffB); PG8_STAGE(PG8_SA(0, 0), a2, voffA);
            PG8_WAIT_V(8); PG8_WAIT_L(0); PG8_BAR; PG8_MMA(1, 0, At, B0); PG8_MMA(1, 1, At, B1); PG8_BAR; PG8_SCHED;
            PG8_LDB(B0, 1, 0); PG8_LDB(B1, 1, 1); PG8_SCHED; PG8_LDA(At, 1, 0); PG8_STAGE(PG8_SA(0, 1), a2 + hstepA, voffA);
            PG8_WAIT_V(8); PG8_WAIT_L(0); PG8_BAR; PG8_MMA(0, 0, At, B0); PG8_MMA(0, 1, At, B1); PG8_BAR; PG8_SCHED;
            PG8_LDA(At, 1, 1); PG8_STAGE(PG8_SB(1, 0), b3, voffB); PG8_STAGE(PG8_SB(1, 1), b3 + hstepB, voffB); PG8_STAGE(PG8_SA(1, 0), a3, voffA);
            PG8_WAIT_V(8); PG8_WAIT_L(0); PG8_BAR; PG8_MMA(1, 0, At, B0); PG8_MMA(1, 1, At, B1); PG8_BAR; PG8_SCHED;
        }
        if (wr == 0) PG8_BAR;
        E(acc, cur, wr, wc, fr, fq);
        if (!has_next) break;
#pragma unroll
        for (int a = 0; a < 2; ++a)
#pragma unroll
            for (int b = 0; b < 2; ++b)
#pragma unroll
                for (int m = 0; m < 4; ++m)
#pragma unroll
                    for (int n = 0; n < 2; ++n) acc[a][b][m][n] = (f32x4){0.f, 0.f, 0.f, 0.f};
        cur = nxt; cA = nA; cB = nB; ++ui;
        if (wr == 1) PG8_BAR;
    }
    PG8_WAIT_V(0);
    PG8_BAR;
#undef PG8_SA
#undef PG8_SB
#undef PG8_STAGE
#undef PG8_LDA
#undef PG8_LDB
#undef PG8_MMA
#undef PG8_WAIT_V
#undef PG8_WAIT_L
#undef PG8_BAR
#undef PG8_SCHED
#undef PG8_APTR
#undef PG8_BPTR
}

typedef f32x4 Acc[2][2][4][2];

template <bool BF32, bool OF32>
struct EpiResid {
    static constexpr bool PERM = false, STAGGER = false;
    const float* base_l; const float* base_c; bf16_t* XBp; float* outf; const float* gate; const float* colscale;
    DI void operator()(const Acc& acc, const Unit& u, int wr, int wc, int fr, int fq) const {
        const bool lat = u.pm < 256; const int bb = lat ? (u.pm >> 5) : 8;
        const size_t rowt = lat ? (size_t)u.pm * 256 : (size_t)(u.pm - 256) * 256;
        const float* bp = (lat ? base_l : base_c) + rowt * DM;
        bf16_t* xp = XBp + (size_t)u.pm * 256 * DM; float* op = outf + (size_t)u.pm * 256 * DM;
        const float* gp = gate + bb * MODW;
        const int col0 = u.pn * 256 + wc * 32 + 4 * fq;
        f32x4 gv[2][2];
#pragma unroll
        for (int bj = 0; bj < 2; ++bj)
#pragma unroll
            for (int n = 0; n < 2; ++n) {
                const int c = col0 + bj * 128 + n * 16;
                gv[bj][n] = *(const f32x4*)(gp + c);
                if (colscale) gv[bj][n] = gv[bj][n] * *(const f32x4*)(colscale + c);
            }
        constexpr int PD = 3;
        f32x4 buf[PD + 1][4]; u32x2 bufh[PD + 1][4];
#define ER_LOAD(g_) do { const int bj_ = (g_) >> 2, n_ = ((g_) >> 1) & 1, ai_ = (g_) & 1; const int c_ = col0 + bj_ * 128 + n_ * 16; const int frx_ = opq(fr); \
            _Pragma("unroll") for (int m_ = 0; m_ < 4; ++m_) { const size_t o_ = (size_t)(ai_ * 128 + wr * 64 + m_ * 16 + frx_) * DM + c_; \
                if (BF32) buf[(g_) & PD][m_] = *(const f32x4*)(bp + o_); else bufh[(g_) & PD][m_] = *(const u32x2*)(xp + o_); } } while (0)
#pragma unroll
        for (int g = 0; g < PD; ++g) ER_LOAD(g);
#pragma unroll
        for (int g = 0; g < 8; ++g) {
            const int bj = g >> 2, n = (g >> 1) & 1, ai = g & 1;
            const int c = col0 + bj * 128 + n * 16;
            if (g + PD < 8) ER_LOAD(g + PD);
            asm volatile("" ::: "memory");
            {
                const int frx = opq(fr);
#pragma unroll
                for (int m = 0; m < 4; ++m) {
                    const size_t o_ = (size_t)(ai * 128 + wr * 64 + m * 16 + frx) * DM + c;
                    f32x4 bv;
                    if (BF32) bv = buf[g & PD][m]; else { const u32x2 hw = bufh[g & PD][m]; bv = (f32x4){bflo(hw.x), bfhi(hw.x), bflo(hw.y), bfhi(hw.y)}; }
                    const f32x4 o = bv + acc[ai][bj][m][n] * gv[bj][n];
                    if (OF32) *(f32x4*)(op + o_) = o; else { u32x2 w; w.x = pk2(o[0], o[1]); w.y = pk2(o[2], o[3]); *(u32x2*)(xp + o_) = w; }
                }
            }
            asm volatile("" ::: "memory");
        }
#undef ER_LOAD
    }
};

struct EpiSwiGLU {
    static constexpr bool PERM = true, STAGGER = false;
    bf16_t* HID;
    DI void operator()(const Acc& acc, const Unit& u, int wr, int wc, int fr, int fq) const {
        const int hc0 = u.pn * 128 + wc * 32 + 8 * fq;
#pragma unroll
        for (int ai = 0; ai < 2; ++ai)
#pragma unroll
            for (int m = 0; m < 4; ++m) {
                const f32x4 g0 = acc[ai][0][m][0], g1 = acc[ai][0][m][1], u0 = acc[ai][1][m][0], u1 = acc[ai][1][m][1];
                const size_t row0 = (size_t)u.pm * 256 + wr * 64 + opq(fr);
                u32x4 w;
                w.x = pk2(silu_f(g0[0]) * u0[0], silu_f(g0[1]) * u0[1]); w.y = pk2(silu_f(g0[2]) * u0[2], silu_f(g0[3]) * u0[3]);
                w.z = pk2(silu_f(g1[0]) * u1[0], silu_f(g1[1]) * u1[1]); w.w = pk2(silu_f(g1[2]) * u1[2], silu_f(g1[3]) * u1[3]);
                *(u32x4*)(HID + (row0 + ai * 128 + m * 16) * FFH + hc0) = w;
                asm volatile("" ::: "memory");
            }
    }
};

struct EpiAttnQKV {
    static constexpr bool PERM = true, STAGGER = false;
    bf16_t* QKV; const float* qg; const float* kg; const float* cosT; const float* sinT;
    DI void operator()(const Acc& acc, const Unit& u, int wr, int wc, int fr, int fq) const {
        const int mode = u.pn < 4 ? 0 : (u.pn == 4 ? 1 : 2);
        const bool lat = u.pm < 256; const int tok0 = (u.pm * 256) & (SEQ - 1);
        const int jb = 8 * fq;
        const float* gp = mode == 0 ? qg : kg;
        f32x4 gn[2][2];
#pragma unroll
        for (int bj = 0; bj < 2; ++bj)
#pragma unroll
            for (int n = 0; n < 2; ++n) gn[bj][n] = *(const f32x4*)(gp + 32 * bj + jb + 4 * n);
        const int outcol = (mode == 0 ? u.pn * 256 : (mode == 1 ? 1024 : 1280)) + wc * 64 + jb;
        const bool rot = mode < 2 && lat;
        f32x4 cb[3][2], sb[3][2];
#define AQ_LOADCS(i_) do { const int t_ = tok0 + ((i_) >> 2) * 128 + wr * 64 + ((i_) & 3) * 16 + opq(fr); \
            _Pragma("unroll") for (int n_ = 0; n_ < 2; ++n_) { cb[(i_) % 2][n_] = *(const f32x4*)(cosT + t_ * 32 + jb + 4 * n_); sb[(i_) % 2][n_] = *(const f32x4*)(sinT + t_ * 32 + jb + 4 * n_); } } while (0)
        if (rot) { AQ_LOADCS(0); }
#pragma unroll
        for (int ai = 0; ai < 2; ++ai)
#pragma unroll
            for (int m = 0; m < 4; ++m) {
                const int rl = ai * 128 + wr * 64 + m * 16 + opq(fr);
                f32x4 csc[2], snc[2];
#pragma unroll
                for (int n = 0; n < 2; ++n) { csc[n] = cb[(ai * 4 + m) % 2][n]; snc[n] = sb[(ai * 4 + m) % 2][n]; }
                if (rot && ai * 4 + m + 1 < 8) AQ_LOADCS(ai * 4 + m + 1);
                f32x4 v[2][2];
#pragma unroll
                for (int bj = 0; bj < 2; ++bj)
#pragma unroll
                    for (int n = 0; n < 2; ++n) v[bj][n] = acc[ai][bj][m][n];
                if (mode < 2) {
                    float ss = 0.f;
#pragma unroll
                    for (int bj = 0; bj < 2; ++bj)
#pragma unroll
                        for (int n = 0; n < 2; ++n) { const f32x4 x = v[bj][n]; ss += (x[0] * x[0] + x[1] * x[1]) + (x[2] * x[2] + x[3] * x[3]); }
                    { const int ln = fr + 16 * fq; ss += shx(ss, 16, ln); ss += shx(ss, 32, ln); }
                    float rs = rsqrtf(ss * (1.0f / 64.0f) + NEPS); if (mode == 0) rs *= 0.125f * 1.4426950408889634f;
#pragma unroll
                    for (int bj = 0; bj < 2; ++bj)
#pragma unroll
                        for (int n = 0; n < 2; ++n) v[bj][n] = v[bj][n] * rs * gn[bj][n];
                    if (lat) {
#pragma unroll
                        for (int n = 0; n < 2; ++n) {
                            const f32x4 cs = csc[n], sn = snc[n];
                            const f32x4 x1 = v[0][n], x2 = v[1][n];
                            v[0][n] = x1 * cs - x2 * sn; v[1][n] = x2 * cs + x1 * sn;
                        }
                    }
                }
                bf16_t* rp = QKV + ((size_t)u.pm * 256 + rl) * 1536 + outcol;
#pragma unroll
                for (int bj = 0; bj < 2; ++bj) {
                    u32x4 w; w.x = pk2(v[bj][0][0], v[bj][0][1]); w.y = pk2(v[bj][0][2], v[bj][0][3]); w.z = pk2(v[bj][1][0], v[bj][1][1]); w.w = pk2(v[bj][1][2], v[bj][1][3]);
                    *(u32x4*)(rp + 32 * bj) = w;
                }
                asm volatile("" ::: "memory");
            }
#undef AQ_LOADCS
    }
};

struct EpiRetQKV {
    static constexpr bool PERM = true, STAGGER = false;
    bf16_t* RQp; bf16_t* RVp; const float* cosT; const float* sinT; float* SSp;
    DI void operator()(const Acc& acc, const Unit& u, int wr, int wc, int fr, int fq) const {
        const bool lat = u.pm < 256; const int tok0 = (u.pm * 256) & (SEQ - 1);
        const int j0 = 32 * wc + 8 * fq;
        const float sc = (u.pn >= 4 && u.pn < 8) ? 0.0625f : 1.0f;
        if (u.pn == 0) { float zf = 0.f; asm volatile("" : "+v"(zf)); *(f32x4*)(SSp + (size_t)u.lt * 256 * 8 + ((wr * 4 + wc) * 64 + fq * 16 + fr) * 4) = (f32x4){zf, zf, zf, zf}; }
        const bool rot = u.pn < 8 && lat;
        f32x4 cb[3][2], sb[3][2];
#define RQ_LOADCS(i_) do { const int t_ = tok0 + ((i_) >> 2) * 128 + wr * 64 + ((i_) & 3) * 16 + opq(fr); \
            _Pragma("unroll") for (int n_ = 0; n_ < 2; ++n_) { cb[(i_) % 3][n_] = *(const f32x4*)(cosT + t_ * 128 + j0 + 4 * n_); sb[(i_) % 3][n_] = *(const f32x4*)(sinT + t_ * 128 + j0 + 4 * n_); } } while (0)
        if (rot) { RQ_LOADCS(0); RQ_LOADCS(1); }
#pragma unroll
        for (int ai = 0; ai < 2; ++ai)
#pragma unroll
            for (int m = 0; m < 4; ++m) {
                const int rl = ai * 128 + wr * 64 + m * 16 + opq(fr);
                if (rot && ai * 4 + m + 2 < 8) RQ_LOADCS(ai * 4 + m + 2);
                f32x4 v[2][2];
#pragma unroll
                for (int bj = 0; bj < 2; ++bj)
#pragma unroll
                    for (int n = 0; n < 2; ++n) v[bj][n] = acc[ai][bj][m][n] * sc;
                if (u.pn < 8 && lat) {
#pragma unroll
                    for (int n = 0; n < 2; ++n) {
                        const f32x4 cs = cb[(ai * 4 + m) % 3][n], sn = sb[(ai * 4 + m) % 3][n];
                        const f32x4 x1 = v[0][n], x2 = v[1][n];
                        v[0][n] = x1 * cs - x2 * sn; v[1][n] = x2 * cs + x1 * sn;
                    }
                }
                const int lrow = u.lt * 256 + rl;
#pragma unroll
                for (int bj = 0; bj < 2; ++bj) {
                    u32x4 w; w.x = pk2(v[bj][0][0], v[bj][0][1]); w.y = pk2(v[bj][0][2], v[bj][0][3]); w.z = pk2(v[bj][1][0], v[bj][1][1]); w.w = pk2(v[bj][1][2], v[bj][1][3]);
                    bf16_t* rp = u.pn < 8 ? RQp + rfrag(u.pn, lrow >> 5, 8 * bj + 2 * wc + (fq >> 1), lrow & 31, fq & 1)
                                          : RVp + (size_t)lrow * 2048 + (u.pn - 8) * 256 + 128 * bj + j0;
                    *(u32x4*)rp = w;
                }
                asm volatile("" ::: "memory");
            }
#undef RQ_LOADCS
    }
};

struct EpiRetGate {
    static constexpr bool PERM = true, STAGGER = false;
    const bf16_t* YF; const bf16_t* YB; const float* SS; bf16_t* Z;
    DI void operator()(const Acc& acc, const Unit& u, int wr, int wc, int fr, int fq) const {
        const int c0 = u.pn * 128 + 32 * wc + 8 * fq, head = u.pn >> 2;
        u32x4 yfb[3], ybb[3]; f32x2_t ssb[3];
#define RG_LOAD(i_) do { const size_t lr_ = (size_t)u.lt * 256 + ((i_) >> 2) * 128 + wr * 64 + ((i_) & 3) * 16 + opq(fr); \
            ssb[(i_) % 3] = *(const f32x2_t*)(SS + (lr_ * 4 + head) * 2); yfb[(i_) % 3] = *(const u32x4*)(YF + lr_ * 2048 + c0); ybb[(i_) % 3] = *(const u32x4*)(YB + lr_ * 2048 + c0); } while (0)
        RG_LOAD(0); RG_LOAD(1);
#pragma unroll
        for (int ai = 0; ai < 2; ++ai)
#pragma unroll
            for (int m = 0; m < 4; ++m) {
                const size_t lrow = (size_t)u.lt * 256 + ai * 128 + wr * 64 + m * 16 + opq(fr);
                if (ai * 4 + m + 2 < 8) RG_LOAD(ai * 4 + m + 2);
                const f32x2_t sq = ssb[(ai * 4 + m) % 3];
                const float rf = rsqrtf(sq.x * (1.0f / 512.0f) + NEPS), rb = rsqrtf(sq.y * (1.0f / 512.0f) + NEPS);
                const u32x4 yf = yfb[(ai * 4 + m) % 3], yb = ybb[(ai * 4 + m) % 3];
                const f32x4 f0 = acc[ai][0][m][0], f1 = acc[ai][0][m][1], b0 = acc[ai][1][m][0], b1 = acc[ai][1][m][1];
                u32x4 w;
                w.x = pk2(silu_f(f0[0]) * bflo(yf.x) * rf + silu_f(b0[0]) * bflo(yb.x) * rb, silu_f(f0[1]) * bfhi(yf.x) * rf + silu_f(b0[1]) * bfhi(yb.x) * rb);
                w.y = pk2(silu_f(f0[2]) * bflo(yf.y) * rf + silu_f(b0[2]) * bflo(yb.y) * rb, silu_f(f0[3]) * bfhi(yf.y) * rf + silu_f(b0[3]) * bfhi(yb.y) * rb);
                w.z = pk2(silu_f(f1[0]) * bflo(yf.z) * rf + silu_f(b1[0]) * bflo(yb.z) * rb, silu_f(f1[1]) * bfhi(yf.z) * rf + silu_f(b1[1]) * bfhi(yb.z) * rb);
                w.w = pk2(silu_f(f1[2]) * bflo(yf.w) * rf + silu_f(b1[2]) * bflo(yb.w) * rb, silu_f(f1[3]) * bfhi(yf.w) * rf + silu_f(b1[3]) * bfhi(yb.w) * rb);
                *(u32x4*)(Z + lrow * 2048 + c0) = w;
                asm volatile("" ::: "memory");
            }
#undef RG_LOAD
    }
};
}

struct Params {
    const float* x; const float* c; const float* ctx; const float* c_ctx; const float* ada_w; const float* ada_b; const float* norm_mix; const float* norm_ffn;
    const float* attn_w_qkv; const float* attn_w_o; const float* attn_q_norm; const float* attn_k_norm; const float* attn_sink;
    const float* pool_w; const float* pool_scale; const float* ret_w_in; const float* ret_w_o; const float* ffn_w_gate; const float* ffn_w_up; const float* ffn_w_down;
    float* out; unsigned char* ws;
};

DI void transpose_item(const float* W, int ldw, int k0, int col0, bf16_t* dst, int ldd, int drow0, LAS float* scr, int lane) {
#pragma unroll 8
    for (int i = 0; i < 32; ++i) { const int kk = 2 * i + (lane >> 5); scr[kk * 33 + (lane & 31)] = W[(size_t)(k0 + kk) * ldw + col0 + (lane & 31)]; }
    asm volatile("s_waitcnt lgkmcnt(0)" ::: "memory");
    const int c = lane & 7;
#pragma unroll
    for (int j = 0; j < 4; ++j) { const int n = (lane >> 3) + 8 * j; const LAS float* s = scr + (8 * c) * 33 + n;
        u32x4 o; o.x = pk2(s[0 * 33], s[1 * 33]); o.y = pk2(s[2 * 33], s[3 * 33]); o.z = pk2(s[4 * 33], s[5 * 33]); o.w = pk2(s[6 * 33], s[7 * 33]);
        *(u32x4*)(dst + (size_t)(drow0 + n) * ldd + k0 + 8 * c) = o; }
    asm volatile("s_waitcnt lgkmcnt(0)" ::: "memory");
}
DI int dst_row_of(int kind, int n0) {
    if (kind == 0) return n0;
    if (kind == 1) return (n0 & ~255) + 128 * ((n0 >> 5) & 1) + 32 * ((n0 >> 6) & 3);
    return 256 * (n0 >> 7) + (n0 & 127) + (kind == 3 ? 128 : 0);
}
DI void transpose_matrix(const float* W, int K, int ldw, int col_off, int ncols, bf16_t* dst, int ldd, int drow_off, int kind, LAS float* scr, int lane, int gw, int NGW, int& cnt) {
    const int nblk = ncols / 32, nitems = (K / 64) * nblk;
    int first = (gw - (cnt % NGW) + NGW) % NGW;
    for (int it = first; it < nitems; it += NGW) {
        const int kb = it / nblk, nb = it % nblk;
        transpose_item(W, ldw, 64 * kb, col_off + 32 * nb, dst, ldd, drow_off + dst_row_of(kind, 32 * nb), scr, lane);
    }
    cnt += nitems;
}

template <bool SRCF32>
DI void prenorm_phase(const float* xl, const float* xc, const bf16_t* XBp, const float* gain, const float* modl, int shi, int sci, bf16_t* H, int rbeg, int mrows, int G, int bid, int wid0) {
    const int tid = opaque_tid(wid0), lane = tid & 63, gw = bid * 8 + __builtin_amdgcn_readfirstlane(tid >> 6), NGW = G * 8;
    constexpr int RW = 4;
    for (int row0 = rbeg + gw * RW; row0 < mrows; row0 += NGW * RW) {
        const bool lat = row0 < MLAT; const int bb = lat ? (row0 >> 13) : 8;
        const float* mp = modl + bb * MODW;
        float s[RW]; float zf = 0.f; asm volatile("" : "+v"(zf)); float epsv = NEPS; asm volatile("" : "+v"(epsv));
        if (SRCF32) {
            const float* src = lat ? xl + (size_t)row0 * DM : xc + (size_t)(row0 - MLAT) * DM;
            f32x4 v[RW][4];
#pragma unroll
            for (int q = 0; q < RW; ++q) {
                s[q] = zf;
#pragma unroll
                for (int j = 0; j < 4; ++j) v[q][j] = __builtin_nontemporal_load((const f32x4*)(src + (size_t)q * DM + 256 * j + 4 * lane));
            }
#pragma unroll
            for (int q = 0; q < RW; ++q)
#pragma unroll
                for (int j = 0; j < 4; ++j) s[q] += (v[q][j][0] * v[q][j][0] + v[q][j][1] * v[q][j][1]) + (v[q][j][2] * v[q][j][2] + v[q][j][3] * v[q][j][3]);
#pragma unroll
            for (int o = 1; o < 64; o <<= 1)
#pragma unroll
                for (int q = 0; q < RW; ++q) s[q] += shx(s[q], o, lane);
#pragma unroll
            for (int j = 0; j < 4; ++j) {
                const int col = 256 * j + 4 * lane;
                const f32x4 g = *(const f32x4*)(gain + col), sc = *(const f32x4*)(mp + sci * DM + col), sh = *(const f32x4*)(mp + shi * DM + col);
                const f32x4 gs = g * (sc + 1.0f);
#pragma unroll
                for (int q = 0; q < RW; ++q) {
                    const float rstd = rsqrtf(s[q] * (1.0f / DM) + epsv);
                    const f32x4 o = v[q][j] * rstd * gs + sh;
                    u32x2 w; w.x = pk2(o[0], o[1]); w.y = pk2(o[2], o[3]);
                    *(u32x2*)(H + (size_t)(row0 + q) * DM + col) = w;
                }
            }
        } else {
            const bf16_t* src = XBp + (size_t)row0 * DM;
            u32x4 v[RW][2];
#pragma unroll
            for (int q = 0; q < RW; ++q) {
                s[q] = zf;
#pragma unroll
                for (int j = 0; j < 2; ++j) v[q][j] = __builtin_nontemporal_load((const u32x4*)(src + (size_t)q * DM + 512 * j + 8 * lane));
            }
#pragma unroll
            for (int q = 0; q < RW; ++q)
#pragma unroll
                for (int j = 0; j < 2; ++j) {
                    const u32x4 w = v[q][j];
                    const float a0 = bflo(w.x), a1 = bfhi(w.x), a2 = bflo(w.y), a3 = bfhi(w.y), a4 = bflo(w.z), a5 = bfhi(w.z), a6 = bflo(w.w), a7 = bfhi(w.w);
                    s[q] += ((a0 * a0 + a1 * a1) + (a2 * a2 + a3 * a3)) + ((a4 * a4 + a5 * a5) + (a6 * a6 + a7 * a7));
                }
#pragma unroll
            for (int o = 1; o < 64; o <<= 1)
#pragma unroll
                for (int q = 0; q < RW; ++q) s[q] += shx(s[q], o, lane);
#pragma unroll
            for (int j = 0; j < 2; ++j) {
                const int col = 512 * j + 8 * lane;
                f32x4 gs[2], sh[2];
#pragma unroll
                for (int t = 0; t < 2; ++t) { gs[t] = *(const f32x4*)(gain + col + 4 * t) * (*(const f32x4*)(mp + sci * DM + col + 4 * t) + 1.0f); sh[t] = *(const f32x4*)(mp + shi * DM + col + 4 * t); }
#pragma unroll
                for (int q = 0; q < RW; ++q) {
                    const float rstd = rsqrtf(s[q] * (1.0f / DM) + epsv);
                    const u32x4 w = v[q][j];
                    const f32x4 x0 = (f32x4){bflo(w.x), bfhi(w.x), bflo(w.y), bfhi(w.y)}, x1 = (f32x4){bflo(w.z), bfhi(w.z), bflo(w.w), bfhi(w.w)};
                    const f32x4 o0 = x0 * rstd * gs[0] + sh[0], o1 = x1 * rstd * gs[1] + sh[1];
                    u32x4 ow; ow.x = pk2(o0[0], o0[1]); ow.y = pk2(o0[2], o0[3]); ow.z = pk2(o1[0], o1[1]); ow.w = pk2(o1[2], o1[3]);
                    *(u32x4*)(H + (size_t)(row0 + q) * DM + col) = ow;
                }
            }
        }
    }
}
template <int HW>
DI void pool_item(const bf16_t* Hn, bf16_t* Pq, int row, int c8) {
    int t, T, rbase;
    if (row < MLAT) { t = row & (SEQ - 1); T = SEQ; rbase = row - t; } else { t = (row - MLAT) & (CTXL - 1); T = CTXL; rbase = row - t; }
    u32x4 w[2 * HW];
#pragma unroll
    for (int k = 0; k < 2 * HW; ++k) { int tt = t - HW + k; tt = tt < 0 ? 0 : (tt > T - 1 ? T - 1 : tt); w[k] = *(const u32x4*)(Hn + (size_t)(rbase + tt) * DM + c8); }
    float a[8]; float cnt = 0.f;
#pragma unroll
    for (int e = 0; e < 8; ++e) a[e] = 0.f;
#pragma unroll
    for (int k = 0; k < 2 * HW; ++k) {
        const int tt = t - HW + k; const float m = (tt >= 0 && tt < T) ? 1.0f : 0.0f; cnt += m;
        a[0] += bflo(w[k].x) * m; a[1] += bfhi(w[k].x) * m; a[2] += bflo(w[k].y) * m; a[3] += bfhi(w[k].y) * m; a[4] += bflo(w[k].z) * m; a[5] += bfhi(w[k].z) * m; a[6] += bflo(w[k].w) * m; a[7] += bfhi(w[k].w) * m;
    }
    const float inv = 1.0f / cnt; const u32x4 c = w[HW];
    u32x4 o;
    o.x = pk2(a[0] * inv - bflo(c.x), a[1] * inv - bfhi(c.x)); o.y = pk2(a[2] * inv - bflo(c.y), a[3] * inv - bfhi(c.y));
    o.z = pk2(a[4] * inv - bflo(c.z), a[5] * inv - bfhi(c.z)); o.w = pk2(a[6] * inv - bflo(c.w), a[7] * inv - bfhi(c.w));
    *(u32x4*)(Pq + (size_t)row * DM + c8) = o;
}
DI void pool_phase(const bf16_t* H, bf16_t* P, int G, int bid, int wid0) {
    const int tid = opaque_tid(wid0), lane = tid & 63, gw = bid * 8 + __builtin_amdgcn_readfirstlane(tid >> 6), NGW = G * 8;
    for (int wi = gw; wi < (MTOT / 2) * 4; wi += NGW) {
        const int rp = wi >> 2, grp = wi & 3, row = 2 * rp + (lane >> 5), c8 = grp * 256 + (lane & 31) * 8;
        if (grp == 0) pool_item<1>(H, P, row, c8); else if (grp == 1) pool_item<2>(H, P, row, c8); else if (grp == 2) pool_item<4>(H, P, row, c8); else pool_item<8>(H, P, row, c8);
    }
}

constexpr int AT_KOFF = 0, AT_VOFF = 128 * 144, AT_PITCH = 144, AT_VPITCH = 192;
DI void attn_phase(LAS unsigned char* lds, const bf16_t* QKV, bf16_t* AO, const float* sink, bool do_ctx, int G, int bid, int wid0) {
    const int tid = opaque_tid(wid0), lane = tid & 63, wid = __builtin_amdgcn_readfirstlane(tid >> 6);
    const int r = lane & 31, hh = lane >> 5, i16 = lane & 15, q4 = i16 >> 2, p4 = i16 & 3, blk = (lane >> 4) & 1;
    const int nunits = 2048 + (do_ctx ? 64 : 0);
    const int vcu = (G % 8 == 0) ? (bid % 8) * (G / 8) + bid / 8 : bid;
    for (int u = vcu; u < nunits; u += G) {
        int b, kvh, qb; bool isctx;
        if (u < 2048) { b = u >> 8; kvh = (u >> 6) & 3; qb = u & 63; isctx = false; } else { const int v = u - 2048; b = v >> 3; kvh = (v >> 1) & 3; qb = v & 1; isctx = true; }
        const size_t qrow0 = isctx ? (size_t)(MLAT + b * CTXL + qb * 128) : (size_t)(b * SEQ + qb * 128);
        const int g = wid >> 1, qh = wid & 1, head = kvh * 4 + g;
        bf16x8 qf[2][4];
#pragma unroll
        for (int qt = 0; qt < 2; ++qt)
#pragma unroll
            for (int s = 0; s < 4; ++s) qf[qt][s] = *(const bf16x8*)(QKV + (qrow0 + qh * 64 + qt * 32 + r) * 1536 + head * 64 + 16 * s + 8 * hh);
        f32x16 o[2][2]; float l[2] = {0.f, 0.f};
#pragma unroll
        for (int a = 0; a < 2; ++a)
#pragma unroll
            for (int c = 0; c < 2; ++c)
#pragma unroll
                for (int e = 0; e < 16; ++e) o[a][c][e] = 0.f;
#define AT_VALID(c_) ((c_) >= 3 || (!isctx && (qb - 1 + (c_)) >= 0 && (qb - 1 + (c_)) <= 63))
#define AT_KROW(c_) ((c_) < 3 ? (size_t)(b * SEQ + (qb - 1 + (c_)) * 128) : (size_t)(MLAT + b * CTXL + ((c_) - 3) * 128))
#define AT_LOAD(c_) do { const size_t kr_ = AT_KROW(c_); _Pragma("unroll") for (int i_ = 0; i_ < 2; ++i_) { const int p_ = tid + 512 * i_, row_ = p_ >> 3, ch_ = p_ & 7; \
            kreg[i_] = *(const u32x4*)(QKV + (kr_ + row_) * 1536 + 1024 + kvh * 64 + ch_ * 8); vreg[i_] = *(const u32x4*)(QKV + (kr_ + row_) * 1536 + 1280 + kvh * 64 + ch_ * 8); } } while (0)
        u32x4 kreg[2], vreg[2];
        int c = 0; while (!AT_VALID(c)) ++c;
        AT_LOAD(c);
        while (c < 5) {
            LDS_BARRIER();
#pragma unroll
            for (int i = 0; i < 2; ++i) {
                const int p = tid + 512 * i, row = p >> 3, ch = p & 7;
                *(LAS u32x4*)(lds + AT_KOFF + row * AT_PITCH + ch * 16) = kreg[i];
                *(LAS u32x4*)(lds + AT_VOFF + row * AT_VPITCH + ch * 16) = vreg[i];
            }
            int cn = c + 1; while (cn < 5 && !AT_VALID(cn)) ++cn;
            if (cn < 5) AT_LOAD(cn);
            LDS_BARRIER();
            const int relbase = (c - 1) * 128;
#pragma unroll 1
            for (int kb32 = 0; kb32 < 4; ++kb32) {
                bf16x8 kf[4];
#pragma unroll
                for (int s = 0; s < 4; ++s) kf[s] = *(const LAS bf16x8*)(lds + AT_KOFF + (kb32 * 32 + r) * AT_PITCH + (16 * s + 8 * hh) * 2);
                bf16x8 vf[2][2];
#pragma unroll
                for (int dt = 0; dt < 2; ++dt)
#pragma unroll
                    for (int s2 = 0; s2 < 2; ++s2) {
                        const LAS unsigned char* vp = lds + AT_VOFF + (kb32 * 32 + 16 * s2 + 4 * hh + q4) * AT_VPITCH + (dt * 32 + 16 * blk) * 2 + 8 * p4;
                        vf[dt][s2] = cat8(trd(vp), trd(vp + 8 * AT_VPITCH));
                    }
#pragma unroll
                for (int qt = 0; qt < 2; ++qt) {
                    const int qlo = qh * 64 + qt * 32;
                    if (c == 0 && kb32 * 32 + 31 < qlo) continue;
                    if (c == 2 && kb32 * 32 > qlo + 31) continue;
                    f32x16 sa;
#pragma unroll
                    for (int e = 0; e < 16; ++e) sa[e] = 0.f;
#pragma unroll
                    for (int s = 0; s < 4; ++s) sa = MFMA32(kf[s], qf[qt][s], sa);
                    const int qi = qlo + r;
                    float ls = 0.f;
                    if (c == 0 || c == 2) {
#pragma unroll
                        for (int e = 0; e < 16; ++e) {
                            float p = __builtin_amdgcn_exp2f(sa[e]);
                            const int rel = relbase + kb32 * 32 + crow(e, hh) - qi; if (rel > 128 || rel < -128) p = 0.f;
                            sa[e] = p; ls += p;
                        }
                    } else {
#pragma unroll
                        for (int e = 0; e < 16; ++e) { const float p = __builtin_amdgcn_exp2f(sa[e]); sa[e] = p; ls += p; }
                    }
                    l[qt] += ls;
                    const bf16x8 p0 = pack8(sa, 0), p1 = pack8(sa, 1);
#pragma unroll
                    for (int dt = 0; dt < 2; ++dt) { o[dt][qt] = MFMA32(vf[dt][0], p0, o[dt][qt]); o[dt][qt] = MFMA32(vf[dt][1], p1, o[dt][qt]); }
                }
            }
            c = cn;
        }
#undef AT_VALID
#undef AT_KROW
#undef AT_LOAD
        const float es = __expf(sink[head]);
#pragma unroll
        for (int qt = 0; qt < 2; ++qt) {
            const float lt = l[qt] + shx(l[qt], 32, lane) + es;
            const float inv = 1.0f / lt;
            bf16_t* op = AO + (qrow0 + qh * 64 + qt * 32 + r) * DM + head * 64;
#pragma unroll
            for (int dt = 0; dt < 2; ++dt)
#pragma unroll
                for (int g4 = 0; g4 < 4; ++g4) {
                    u32x2 w; w.x = pk2(o[dt][qt][4 * g4] * inv, o[dt][qt][4 * g4 + 1] * inv); w.y = pk2(o[dt][qt][4 * g4 + 2] * inv, o[dt][qt][4 * g4 + 3] * inv);
                    *(u32x2*)(op + dt * 32 + 8 * g4 + 4 * hh) = w;
                }
        }
    }
}

DI float ret_log2g(int h, int dir) { return log2f(1.0f - exp2f(-5.0f - (dir ? 0.5f : 0.0f) - (float)h)); }
constexpr int RI_PITCH = 1040;
DI void ret_intra_phase(LAS unsigned char* lds, const bf16_t* RQp, const bf16_t* RVp, bf16_t* YF, bf16_t* YB, int G, int bid, int wid0) {
    const int tid = opaque_tid(wid0), lane = tid & 63, wid = __builtin_amdgcn_readfirstlane(tid >> 6);
    const int r = lane & 31, hh = lane >> 5, i16 = lane & 15, q4 = i16 >> 2, p4 = i16 & 3, blk = (lane >> 4) & 1;
    const int it = wid & 3, dir = wid >> 2;
    for (int u = bid; u < 1056; u += G) {
        const int b4 = u / 264, rem = u % 264, h = rem / 66, ch = rem % 66;
        const size_t lrow0 = ch < 64 ? (size_t)(b4 * SEQ + ch * 128) : (size_t)(4 * SEQ + b4 * CTXL + (ch - 64) * 128);
        __syncthreads();
#pragma unroll 4
        for (int i = 0; i < 16; ++i) {
            const int p = tid + 512 * i, row = p >> 6, cn = p & 63;
            *(LAS u32x4*)(lds + row * RI_PITCH + cn * 16) = *(const u32x4*)(RVp + (lrow0 + row) * 2048 + h * 512 + cn * 8);
        }
        const bf16_t* qp = RQp + rfrag(h, (int)(lrow0 >> 5) + it, 0, r, hh);
        const float l2g = ret_log2g(h, dir);
        bf16x8 pf[4][2];
#pragma unroll
        for (int jt = 0; jt < 4; ++jt) {
            const bool need = dir == 0 ? (jt <= it) : (jt >= it);
            if (need) {
                f32x16 sa;
#pragma unroll
                for (int e = 0; e < 16; ++e) sa[e] = 0.f;
                const bf16_t* kp = RQp + rfrag(4 + h, (int)(lrow0 >> 5) + jt, 0, r, hh);
#pragma unroll 8
                for (int s = 0; s < 16; ++s) {
                    const bf16x8 kf = *(const bf16x8*)(kp + 512 * s);
                    sa = MFMA32(kf, *(const bf16x8*)(qp + 512 * s), sa);
                }
                const int i = it * 32 + r;
#pragma unroll
                for (int e = 0; e < 16; ++e) {
                    const int j = jt * 32 + crow(e, hh); const int diff = dir == 0 ? i - j : j - i;
                    sa[e] = diff >= 0 ? sa[e] * exp2f((float)diff * l2g) : 0.f;
                }
                pf[jt][0] = pack8(sa, 0); pf[jt][1] = pack8(sa, 1);
            } else { pf[jt][0] = (bf16x8){0, 0, 0, 0, 0, 0, 0, 0}; pf[jt][1] = pf[jt][0]; }
        }
        __syncthreads();
        bf16_t* Y = (dir ? YB : YF) + (lrow0 + it * 32 + r) * 2048 + h * 512;
#pragma unroll 1
        for (int vt = 0; vt < 16; ++vt) {
            f32x16 acc;
#pragma unroll
            for (int e = 0; e < 16; ++e) acc[e] = 0.f;
#pragma unroll
            for (int jt = 0; jt < 4; ++jt) {
                const bool need = dir == 0 ? (jt <= it) : (jt >= it);
                if (need) {
#pragma unroll
                    for (int s2 = 0; s2 < 2; ++s2) {
                        const LAS unsigned char* vp = lds + (jt * 32 + 16 * s2 + 4 * hh + q4) * RI_PITCH + (vt * 32 + 16 * blk) * 2 + 8 * p4;
                        acc = MFMA32(cat8(trd(vp), trd(vp + 8 * RI_PITCH)), pf[jt][s2], acc);
                    }
                }
            }
#pragma unroll
            for (int g4 = 0; g4 < 4; ++g4) {
                u32x2 w; w.x = pk2(acc[4 * g4], acc[4 * g4 + 1]); w.y = pk2(acc[4 * g4 + 2], acc[4 * g4 + 3]);
                *(u32x2*)(Y + vt * 32 + 8 * g4 + 4 * hh) = w;
            }
        }
    }
}

#define XB_TMO      128
#define XB_XCNT(j)  (256  + 64 * (j))
#define XB_XSUB(j)  (1280 + 64 * (j))
#define XB_XGEN(j)  (2304 + 64 * (j))
#define XB_TOP      3328
#define XB_TOPGEN   3392
#define XCD_BAR_WORDS 3456
#define XB_SPIN_CAP (1u << 18)
DI unsigned xb_ld(unsigned* p)              { return __hip_atomic_load(p, __ATOMIC_RELAXED, __HIP_MEMORY_SCOPE_AGENT); }
DI unsigned xb_add(unsigned* p, unsigned v) { return __hip_atomic_fetch_add(p, v, __ATOMIC_RELAXED, __HIP_MEMORY_SCOPE_AGENT); }
DI unsigned xb_xcc_id() { return (unsigned)__builtin_amdgcn_s_getreg((3 << 11) | 20) & 0xFu; }
#define XB_SPIN(cond, bar) do { unsigned _sp = 0; while (cond) { __builtin_amdgcn_s_sleep(1); \
    if ((++_sp & 255u) == 0u) { if (xb_ld(&(bar)[XB_TMO])) break; if (_sp > XB_SPIN_CAP) { atomicAdd(&(bar)[XB_TMO], 1u); break; } } } } while (0)
struct XcdBarrier { unsigned* bar; unsigned x; volatile LAS unsigned* st; };
DI XcdBarrier xcd_barrier_post(unsigned* bar, volatile LAS unsigned* st) {
    XcdBarrier b; b.bar = bar; b.x = xb_xcc_id(); b.st = st;
    if (threadIdx.x == 0) (void)xb_add(&bar[XB_XCNT(b.x)], 1u);
    return b;
}
DI void xcd_barrier_complete(unsigned* bar, unsigned x, unsigned& nloc, unsigned& nx) {
    const unsigned G = gridDim.x * gridDim.y * gridDim.z;
    unsigned sum, cnt, mine, sp = 0u;
    for (;;) {
        sum = 0u; cnt = 0u; mine = 0u;
#pragma unroll
        for (unsigned j = 0; j < 16; ++j) { const unsigned c = xb_ld(&bar[XB_XCNT(j)]); sum += c; cnt += (c > 0u) ? 1u : 0u; mine = (j == x) ? c : mine; }
        if (sum == G) break;
        __builtin_amdgcn_s_sleep(1);
        if ((++sp & 255u) == 0u) { if (xb_ld(&bar[XB_TMO])) break; if (sp > XB_SPIN_CAP) { atomicAdd(&bar[XB_TMO], 1u); break; } }
    }
    nloc = mine > 0u ? mine : 1u; nx = cnt > 0u ? cnt : 1u;
}
DI void xcd_barrier(const XcdBarrier& b) {
    asm volatile("s_waitcnt vmcnt(0)" ::: "memory");
    __syncthreads();
    if (threadIdx.x == 0) {
        unsigned* bar = b.bar;
        __builtin_amdgcn_s_waitcnt(0);
        unsigned nloc = b.st[0], nx = b.st[1];
        if (nloc == 0u) { xcd_barrier_complete(bar, b.x, nloc, nx); b.st[0] = nloc; b.st[1] = nx; }
        const unsigned old = xb_add(&bar[XB_XSUB(b.x)], 1u);
        const unsigned gen = old / nloc;
        if (old + 1u == (gen + 1u) * nloc) {
            __builtin_amdgcn_fence(__ATOMIC_RELEASE, "agent");
            asm volatile("s_waitcnt vmcnt(0)" ::: "memory");
            const unsigned og = xb_add(&bar[XB_TOP], 1u);
            const unsigned tg = og / nx;
            if (og + 1u == (tg + 1u) * nx) xb_add(&bar[XB_TOPGEN], 1u);
            else XB_SPIN(xb_ld(&bar[XB_TOPGEN]) == tg, bar);
            __builtin_amdgcn_fence(__ATOMIC_ACQUIRE, "agent");
            xb_add(&bar[XB_XGEN(b.x)], 1u);
            asm volatile("s_waitcnt vmcnt(0)" ::: "memory");
        } else {
            XB_SPIN(xb_ld(&bar[XB_XGEN(b.x)]) == gen, bar);
            __builtin_amdgcn_fence(__ATOMIC_ACQUIRE, "agent");
            asm volatile("s_waitcnt vmcnt(0)" ::: "memory");
        }
    }
    __syncthreads();
}

constexpr int RS_KS = 0, RS_KP = 528, RS_VS = 128 * 528, RS_VP = 192, RS_ST = RS_VS + 128 * 192, RS_SP = 528;
DI size_t rs_row0(int step, int dir, int b4) {
    const int ch = dir == 0 ? (step < 2 ? 64 + step : step - 2) : 65 - step;
    return ch < 64 ? (size_t)(b4 * SEQ + ch * 128) : (size_t)(4 * SEQ + b4 * CTXL + (ch - 64) * 128);
}
DI void ret_scan_phase(LAS unsigned char* lds, const bf16_t* RQp, const bf16_t* RVp, bf16_t* YF, bf16_t* YB, float* SS, unsigned* ctl, int cid, int G, int bid, int wid0) {
    const int tid = opaque_tid(wid0), lane = tid & 63, wid = __builtin_amdgcn_readfirstlane(tid >> 6);
    const int r = lane & 31, hh = lane >> 5, i16 = lane & 15, q4 = i16 >> 2, p4 = i16 & 3, blk = (lane >> 4) & 1;
    const int c16 = lane & 15, rq = lane >> 4;
    for (int item0 = bid; item0 < 256; item0 += G) {
        int item = item0;
        if (G == 256) {
            volatile LAS unsigned* bw = (volatile LAS unsigned*)(lds + LDS_BYTES - 16);
            __syncthreads();
            if (tid == 0) {
                bool dyn = true;
#pragma unroll
                for (int j = 0; j < 16; ++j) { const unsigned c = xb_ld(&ctl[XB_XCNT(j)]); dyn = dyn && (c == (j < 8 ? 32u : 0u)); }
                unsigned it;
                if (dyn) { const unsigned x = xb_xcc_id(); const unsigned idx = xb_add(&ctl[4096 + (cid * 16 + x) * 64], 1u); it = (x < 8u && idx < 32u) ? x * 32u + idx : 0xffffffffu; }
                else { const int xcd = item0 & 7, idx = item0 >> 3; it = (unsigned)(((xcd * 4 + (idx >> 3)) << 3) | (idx & 7)); }
                bw[2] = it;
            }
            __syncthreads();
            item = (int)bw[2];
            if (item < 0) item = item0;
        }
        const int sl = item & 7, dir = (item >> 3) & 1, h = (item >> 4) & 3, b4 = item >> 6;
        bf16_t* Y = dir ? YB : YF;
        const float l2g = ret_log2g(h, dir);
        f32x16 S[2];
#pragma unroll
        for (int e = 0; e < 16; ++e) { S[0][e] = 0.f; S[1][e] = 0.f; }
        __syncthreads();
        for (int i = tid; i < 64 * RS_SP / 4; i += 512) *(LAS unsigned*)(lds + RS_ST + 4 * i) = 0u;
        const float cdec = exp2f(l2g * 128.0f);
        const int vrow = tid >> 3, vc16 = tid & 7;
        const int kldso = RS_KS + ((tid >> 1) & 31) * RS_KP + (16 * ((tid >> 6) & 7) + 8 * (tid & 1)) * 2;
        const int itok = 16 * wid + c16;
        const float qd = exp2f(l2g * (float)(dir ? 128 - itok : itok + 1));
        const float fi = exp2f(l2g * (float)(dir ? -itok : itok - 127));
        u32x4 kreg[8], vreg[2]; bf16x8 qn[8];
#define RS_LOAD(step_) do { const size_t l_ = rs_row0((step_), dir, b4); \
            _Pragma("unroll") for (int i_ = 0; i_ < 8; ++i_) kreg[i_] = *(const u32x4*)(RQp + rfrag(4 + h, (int)(l_ >> 5), 0, 0, 0) + (size_t)(tid + 512 * i_) * 8); \
            _Pragma("unroll") for (int i_ = 0; i_ < 2; ++i_) vreg[i_] = *(const u32x4*)(RVp + (l_ + vrow + 64 * i_) * 2048 + h * 512 + sl * 64 + vc16 * 8); \
            { const bf16_t* qp_ = RQp + rfrag(h, (int)(l_ >> 5) + (wid >> 1), rq >> 1, 16 * (wid & 1) + c16, rq & 1); \
              _Pragma("unroll") for (int s_ = 0; s_ < 8; ++s_) qn[s_] = *(const bf16x8*)(qp_ + 1024 * s_); } } while (0)
        RS_LOAD(0);
#pragma unroll 1
        for (int step = 0; step < 66; ++step) {
            const size_t lrow0 = rs_row0(step, dir, b4);
#pragma unroll
            for (int i = 0; i < 8; ++i) *(LAS u32x4*)(lds + kldso + (i >> 1) * 32 * RS_KP + (i & 1) * 256) = kreg[i];
#pragma unroll
            for (int i = 0; i < 2; ++i) {
                const int row = vrow + 64 * i; const u32x4 w = vreg[i];
                const float kd = exp2f(l2g * (float)(dir ? row : 127 - row));
                u32x4 o; o.x = pk2(bflo(w.x) * kd, bfhi(w.x) * kd); o.y = pk2(bflo(w.y) * kd, bfhi(w.y) * kd); o.z = pk2(bflo(w.z) * kd, bfhi(w.z) * kd); o.w = pk2(bflo(w.w) * kd, bfhi(w.w) * kd);
                *(LAS u32x4*)(lds + RS_VS + row * RS_VP + vc16 * 16) = o;
            }
            bf16x8 qf[8];
#pragma unroll
            for (int s = 0; s < 8; ++s) qf[s] = qn[s];
            if (step + 1 < 66) RS_LOAD(step + 1);
            LDS_BARRIER();
            if (wid < 4) {
            {
#pragma unroll
                for (int e = 0; e < 16; ++e) { S[0][e] *= cdec; S[1][e] *= cdec; }
#pragma unroll
                for (int s = 0; s < 8; ++s) {
                    const LAS unsigned char* kp = lds + RS_KS + (16 * s + 8 * hh + q4) * RS_KP + (wid * 32 + 16 * blk) * 2 + 8 * p4;
                    const bf16x8 ka = cat8(trd(kp), trd(kp + 4 * RS_KP));
#pragma unroll
                    for (int vt = 0; vt < 2; ++vt) {
                        const LAS unsigned char* vp = lds + RS_VS + (16 * s + 8 * hh + q4) * RS_VP + (vt * 32 + 16 * blk) * 2 + 8 * p4;
                        S[vt] = MFMA32(ka, cat8(trd(vp), trd(vp + 4 * RS_VP)), S[vt]);
                    }
                }
            }
            {
                f32x4 acc[4];
#pragma unroll
                for (int t = 0; t < 4; ++t) acc[t] = (f32x4){0.f, 0.f, 0.f, 0.f};
                const LAS unsigned char* sp = lds + RS_ST + c16 * RS_SP + 16 * rq;
#pragma unroll
                for (int s = 0; s < 8; ++s)
#pragma unroll
                    for (int t = 0; t < 4; ++t) acc[t] = __builtin_amdgcn_mfma_f32_16x16x32_bf16(*(const LAS bf16x8*)(sp + t * 16 * RS_SP + 64 * s), qf[s], acc[t], 0, 0, 0);
#pragma unroll
                for (int t = 0; t < 4; ++t) acc[t] = acc[t] * qd;
#pragma unroll
                for (int p = 0; p < 4; ++p) {
                    const bool need = dir == 0 ? (2 * p <= wid) : (2 * p + 1 >= wid);
                    if (need) {
                        f32x4 sc0 = (f32x4){0.f, 0.f, 0.f, 0.f}, sc1 = (f32x4){0.f, 0.f, 0.f, 0.f};
                        const LAS unsigned char* kq0 = lds + RS_KS + (32 * p + c16) * RS_KP + 16 * rq;
#pragma unroll
                        for (int s = 0; s < 8; ++s) {
                            sc0 = __builtin_amdgcn_mfma_f32_16x16x32_bf16(*(const LAS bf16x8*)(kq0 + 64 * s), qf[s], sc0, 0, 0, 0);
                            sc1 = __builtin_amdgcn_mfma_f32_16x16x32_bf16(*(const LAS bf16x8*)(kq0 + 16 * RS_KP + 64 * s), qf[s], sc1, 0, 0, 0);
                        }
                        float v0[4], v1[4];
#pragma unroll
                        for (int e = 0; e < 4; ++e) {
                            const int j0 = 32 * p + 4 * rq + e, j1 = j0 + 16;
                            const bool k0 = dir == 0 ? (j0 <= itok) : (j0 >= itok), k1 = dir == 0 ? (j1 <= itok) : (j1 >= itok);
                            v0[e] = k0 ? sc0[e] * fi : 0.f; v1[e] = k1 ? sc1[e] * fi : 0.f;
                        }
                        u32x4 pw; pw.x = pk2(v0[0], v0[1]); pw.y = pk2(v0[2], v0[3]); pw.z = pk2(v1[0], v1[1]); pw.w = pk2(v1[2], v1[3]);
                        const bf16x8 pb = __builtin_bit_cast(bf16x8, pw);
#pragma unroll
                        for (int t = 0; t < 4; ++t) {
                            const LAS unsigned char* vp = lds + RS_VS + (32 * p + 4 * rq + (c16 >> 2)) * RS_VP + (16 * t) * 2 + 8 * (c16 & 3);
                            acc[t] = __builtin_amdgcn_mfma_f32_16x16x32_bf16(cat8(trd(vp), trd(vp + 16 * RS_VP)), pb, acc[t], 0, 0, 0);
                        }
                    }
                }
                bf16_t* yp = Y + (lrow0 + itok) * 2048 + h * 512 + sl * 64 + 4 * rq;
                float ssq = 0.f;
#pragma unroll
                for (int t = 0; t < 4; ++t) {
                    const float y0 = acc[t][0], y1 = acc[t][1], y2 = acc[t][2], y3 = acc[t][3];
                    ssq += (y0 * y0 + y1 * y1) + (y2 * y2 + y3 * y3);
                    u32x2 w; w.x = pk2(y0, y1); w.y = pk2(y2, y3);
                    *(u32x2*)(yp + 16 * t) = w;
                }
                ssq += shx(ssq, 16, lane); ssq += shx(ssq, 32, lane);
                if (rq == 0) unsafeAtomicAdd(SS + ((lrow0 + itok) * 4 + h) * 2 + dir, ssq);
            }
            } else {
            {
                f32x4 acc[4];
#pragma unroll
                for (int t = 0; t < 4; ++t) acc[t] = (f32x4){0.f, 0.f, 0.f, 0.f};
                const LAS unsigned char* sp = lds + RS_ST + c16 * RS_SP + 16 * rq;
#pragma unroll
                for (int s = 0; s < 8; ++s)
#pragma unroll
                    for (int t = 0; t < 4; ++t) acc[t] = __builtin_amdgcn_mfma_f32_16x16x32_bf16(*(const LAS bf16x8*)(sp + t * 16 * RS_SP + 64 * s), qf[s], acc[t], 0, 0, 0);
#pragma unroll
                for (int t = 0; t < 4; ++t) acc[t] = acc[t] * qd;
#pragma unroll
                for (int p = 0; p < 4; ++p) {
                    const bool need = dir == 0 ? (2 * p <= wid) : (2 * p + 1 >= wid);
                    if (need) {
                        f32x4 sc0 = (f32x4){0.f, 0.f, 0.f, 0.f}, sc1 = (f32x4){0.f, 0.f, 0.f, 0.f};
                        const LAS unsigned char* kq0 = lds + RS_KS + (32 * p + c16) * RS_KP + 16 * rq;
#pragma unroll
                        for (int s = 0; s < 8; ++s) {
                            sc0 = __builtin_amdgcn_mfma_f32_16x16x32_bf16(*(const LAS bf16x8*)(kq0 + 64 * s), qf[s], sc0, 0, 0, 0);
                            sc1 = __builtin_amdgcn_mfma_f32_16x16x32_bf16(*(const LAS bf16x8*)(kq0 + 16 * RS_KP + 64 * s), qf[s], sc1, 0, 0, 0);
                        }
                        float v0[4], v1[4];
#pragma unroll
                        for (int e = 0; e < 4; ++e) {
                            const int j0 = 32 * p + 4 * rq + e, j1 = j0 + 16;
                            const bool k0 = dir == 0 ? (j0 <= itok) : (j0 >= itok), k1 = dir == 0 ? (j1 <= itok) : (j1 >= itok);
                            v0[e] = k0 ? sc0[e] * fi : 0.f; v1[e] = k1 ? sc1[e] * fi : 0.f;
                        }
                        u32x4 pw; pw.x = pk2(v0[0], v0[1]); pw.y = pk2(v0[2], v0[3]); pw.z = pk2(v1[0], v1[1]); pw.w = pk2(v1[2], v1[3]);
                        const bf16x8 pb = __builtin_bit_cast(bf16x8, pw);
#pragma unroll
                        for (int t = 0; t < 4; ++t) {
                            const LAS unsigned char* vp = lds + RS_VS + (32 * p + 4 * rq + (c16 >> 2)) * RS_VP + (16 * t) * 2 + 8 * (c16 & 3);
                            acc[t] = __builtin_amdgcn_mfma_f32_16x16x32_bf16(cat8(trd(vp), trd(vp + 16 * RS_VP)), pb, acc[t], 0, 0, 0);
                        }
                    }
                }
                bf16_t* yp = Y + (lrow0 + itok) * 2048 + h * 512 + sl * 64 + 4 * rq;
                float ssq = 0.f;
#pragma unroll
                for (int t = 0; t < 4; ++t) {
                    const float y0 = acc[t][0], y1 = acc[t][1], y2 = acc[t][2], y3 = acc[t][3];
                    ssq += (y0 * y0 + y1 * y1) + (y2 * y2 + y3 * y3);
                    u32x2 w; w.x = pk2(y0, y1); w.y = pk2(y2, y3);
                    *(u32x2*)(yp + 16 * t) = w;
                }
                ssq += shx(ssq, 16, lane); ssq += shx(ssq, 32, lane);
                if (rq == 0) unsafeAtomicAdd(SS + ((lrow0 + itok) * 4 + h) * 2 + dir, ssq);
            }
            {
#pragma unroll
                for (int e = 0; e < 16; ++e) { S[0][e] *= cdec; S[1][e] *= cdec; }
#pragma unroll
                for (int s = 0; s < 8; ++s) {
                    const LAS unsigned char* kp = lds + RS_KS + (16 * s + 8 * hh + q4) * RS_KP + (wid * 32 + 16 * blk) * 2 + 8 * p4;
                    const bf16x8 ka = cat8(trd(kp), trd(kp + 4 * RS_KP));
#pragma unroll
                    for (int vt = 0; vt < 2; ++vt) {
                        const LAS unsigned char* vp = lds + RS_VS + (16 * s + 8 * hh + q4) * RS_VP + (vt * 32 + 16 * blk) * 2 + 8 * p4;
                        S[vt] = MFMA32(ka, cat8(trd(vp), trd(vp + 4 * RS_VP)), S[vt]);
                    }
                }
            }
            }
            LDS_BARRIER();
#pragma unroll
            for (int vt = 0; vt < 2; ++vt)
#pragma unroll
                for (int g4 = 0; g4 < 4; ++g4) {
                    u32x2 w; w.x = pk2(S[vt][4 * g4], S[vt][4 * g4 + 1]); w.y = pk2(S[vt][4 * g4 + 2], S[vt][4 * g4 + 3]);
                    *(LAS u32x2*)(lds + RS_ST + (vt * 32 + r) * RS_SP + (wid * 32 + 8 * g4 + 4 * hh) * 2) = w;
                }
        }
#undef RS_LOAD
    }
}

#define REP_PRO 1
#define REP_NORM 1
#define REP_GQKV 1
#define REP_ATTN 1
#define REP_GRQKV 1
#define REP_RIRS 1
#define REP_RI 1
#define REP_GGU 1
#define REP_SYNC 0
#define REP_GDOWN 0
#define REP_GWO 0
#define REP_GGATE 1
#define REP_GRWO 0
#define REPEAT(n) _Pragma("unroll 1") for (int rep_ = 0; rep_ < (n); ++rep_)
#define REPEAT2(n) _Pragma("unroll 1") for (int rep2_ = 0; rep2_ < (n); ++rep2_)
__global__ void __launch_bounds__(512) fwd_megakernel(Params P) {
    extern __shared__ __attribute__((aligned(16))) unsigned char lds_raw[];
    LAS unsigned char* lds = (LAS unsigned char*)lds_raw;
    cg::grid_group grid = cg::this_grid();
    const int G = gridDim.x, bid = blockIdx.x;
    const int wid0 = __builtin_amdgcn_readfirstlane(threadIdx.x >> 6);
    volatile LAS unsigned* bst = (volatile LAS unsigned*)(lds + LDS_BYTES - 16);
    if (threadIdx.x < 4) bst[threadIdx.x] = 0u;
    __syncthreads();
    const XcdBarrier xbar = xcd_barrier_post((unsigned*)(P.ws + WS_CTL), bst);
#define GSYNC() xcd_barrier(xbar)
    unsigned char* ws = P.ws;
#define MOD ((float*)(ws + WS_MOD))
#define ROPEA_C ((float*)(ws + WS_ROPEA))
#define ROPEA_S (ROPEA_C + SEQ * 32)
#define ROPER_C ((float*)(ws + WS_ROPER))
#define ROPER_S (ROPER_C + SEQ * 128)
#define XB ((bf16_t*)(ws + WS_XB))
#define SS ((float*)(ws + WS_SS))
#define WQKV ((bf16_t*)(ws + WS_WQKV))
#define WAO ((bf16_t*)(ws + WS_WAO))
#define WP ((bf16_t*)(ws + WS_WP))
#define WIN ((bf16_t*)(ws + WS_WIN))
#define WRO ((bf16_t*)(ws + WS_WRO))
#define WGU ((bf16_t*)(ws + WS_WGU))
#define WD ((bf16_t*)(ws + WS_WD))
#define H ((bf16_t*)(ws + WS_H))
#define QKV ((bf16_t*)(ws + WS_QKV))
#define AO ((bf16_t*)(ws + WS_AO))
#define HID ((bf16_t*)(ws + WS_HID))
#define POOLED ((bf16_t*)(ws + WS_POOLED))
#define RQ ((bf16_t*)(ws + WS_RQKV))
#define RV ((bf16_t*)(ws + WS_RQKV + 132 * MiB))
#define YF ((bf16_t*)(ws + WS_YF))
#define YB ((bf16_t*)(ws + WS_YB))
#define Z ((bf16_t*)(ws + WS_Z))
    REPEAT(REP_PRO) {
        const int tid = opaque_tid(wid0), lane = tid & 63, wid = __builtin_amdgcn_readfirstlane(tid >> 6);
        const int gw = bid * 8 + wid, NGW = G * 8, gtid = bid * 512 + tid, NT = G * 512;
        LAS float* sc = (LAS float*)lds;
        LAS float* part = (LAS float*)(lds + 36864);
        for (int blk = bid; blk < 192; blk += G) {
            __syncthreads();
            for (int i = tid; i < 9 * DM; i += 512) { const int bb = i >> 10, k = i & 1023; const float v = bb < 8 ? P.c[bb * DM + k] : P.c_ctx[k]; sc[i] = silu_f(v); }
            __syncthreads();
            const int col = tid & 127, kq = tid >> 7;
            const int idx = blk * 128 + col, l = idx / MODW, n = idx % MODW;
            const float* w = P.ada_w + (size_t)l * DM * MODW + n + (size_t)(kq * 256) * MODW;
            float a[9];
#pragma unroll
            for (int bb = 0; bb < 9; ++bb) a[bb] = 0.f;
#pragma unroll 8
            for (int k = 0; k < 256; ++k) {
                const float wv = w[(size_t)k * MODW];
#pragma unroll
                for (int bb = 0; bb < 9; ++bb) a[bb] += sc[bb * DM + kq * 256 + k] * wv;
            }
#pragma unroll
            for (int bb = 0; bb < 9; ++bb) part[(kq * 9 + bb) * 128 + col] = a[bb];
            __syncthreads();
            if (kq == 0) {
                const float bv = P.ada_b[l * MODW + n];
#pragma unroll
                for (int bb = 0; bb < 9; ++bb) MOD[(l * 9 + bb) * MODW + n] = ((part[bb * 128 + col] + part[(9 + bb) * 128 + col]) + (part[(18 + bb) * 128 + col] + part[(27 + bb) * 128 + col])) + bv;
            }
        }
        __syncthreads();
        if (REP_GDOWN + REP_GWO + REP_GRWO > 0) for (int i = gtid; i < 9 * MODW; i += NT) ((float*)(ws + WS_ZERO))[i] = 0.f;
        for (int i = gtid; i < SEQ * 32; i += NT) {
            const int t = i >> 5, j = i & 31; const float pos = (float)(j < 16 ? (t >> 6) : (t & 63));
            const float inv = powf(10000.0f, -(float)(j & 15) / 16.0f); const float ang = pos * inv;
            ROPEA_C[i] = cosf(ang); ROPEA_S[i] = sinf(ang);
        }
        for (int i = gtid; i < SEQ * 128; i += NT) {
            const int t = i >> 7, j = i & 127;
            const float inv = powf(10000.0f, -((float)j / 127.0f)); const float ang = (float)t * inv;
            ROPER_C[i] = cosf(ang); ROPER_S[i] = sinf(ang);
        }
        LAS float* scr = (LAS float*)(lds + 57344 + wid * 8704);
        int cnt = 0;
        for (int s = 0; s < 2; ++s) {
            transpose_matrix(P.attn_w_qkv + (size_t)s * DM * 1536, DM, 1536, 0, 1536, WQKV + (size_t)s * 1536 * DM, DM, 0, 1, scr, lane, gw, NGW, cnt);
            transpose_matrix(P.attn_w_o + (size_t)s * DM * DM, DM, DM, 0, DM, WAO + (size_t)s * DM * DM, DM, 0, 0, scr, lane, gw, NGW, cnt);
        }
        for (int g = 0; g < 4; ++g) transpose_matrix(P.pool_w + (size_t)g * 256 * 256, 256, 256, 0, 256, WP, 256, g * 256, 0, scr, lane, gw, NGW, cnt);
        transpose_matrix(P.ret_w_in, DM, 8192, 0, 4096, WIN, DM, 0, 0, scr, lane, gw, NGW, cnt);
        transpose_matrix(P.ret_w_in, DM, 8192, 4096, 2048, WIN, DM, 4096, 2, scr, lane, gw, NGW, cnt);
        transpose_matrix(P.ret_w_in, DM, 8192, 6144, 2048, WIN, DM, 4096, 3, scr, lane, gw, NGW, cnt);
        transpose_matrix(P.ret_w_o, 2048, DM, 0, DM, WRO, 2048, 0, 0, scr, lane, gw, NGW, cnt);
        for (int l = 0; l < 4; ++l) {
            transpose_matrix(P.ffn_w_gate + (size_t)l * DM * FFH, DM, FFH, 0, FFH, WGU + (size_t)l * 5632 * DM, DM, 0, 2, scr, lane, gw, NGW, cnt);
            transpose_matrix(P.ffn_w_up + (size_t)l * DM * FFH, DM, FFH, 0, FFH, WGU + (size_t)l * 5632 * DM, DM, 0, 3, scr, lane, gw, NGW, cnt);
            transpose_matrix(P.ffn_w_down + (size_t)l * FFH * DM, FFH, DM, 0, DM, WD + (size_t)l * DM * FFH, FFH, 0, 0, scr, lane, gw, NGW, cnt);
        }
        grid.sync();
    }

#pragma unroll 1
    for (int layer = 0; layer < 4; ++layer) {
        const int kind = layer % 3, slot = layer / 3;
        const float* modl = MOD + (size_t)layer * 9 * MODW;
        const int ntm = layer < 3 ? NTILE_M : 256;
        if (layer == 0) { prenorm_phase<true>(P.x, P.ctx, XB, P.norm_mix + layer * DM, modl, 0, 1, H, 0, MTOT, G, bid, wid0); GSYNC(); }
        if (kind == 0) {
            REPEAT(REP_GQKV) {
                pg8::Gemm g{H, WQKV + (size_t)slot * 1536 * DM, DM, DM, DM, 0, 0}; pg8::Sched S; S.init(NTILE_M, 6, G, bid, NTILE_M, 0, 0);
                pg8::EpiAttnQKV E{QKV, P.attn_q_norm + slot * 64, P.attn_k_norm + slot * 64, ROPEA_C, ROPEA_S};
                pg8::gemm_phase(lds, g, S, E, wid0);
                GSYNC();
            }
            REPEAT(REP_ATTN) { attn_phase(lds, QKV, AO, P.attn_sink + slot * 16, layer < 3, G, bid, wid0); GSYNC(); }
            {
                pg8::Gemm g{AO, WAO + (size_t)slot * DM * DM, DM, DM, DM, 0, 0}; pg8::Sched S; S.init(256, 4, G, bid, 256, 0, 0);
                if (layer == 0) { pg8::EpiResid<true, false> E{P.x, P.ctx, XB, P.out, modl + 2 * DM, nullptr}; pg8::gemm_phase(lds, g, S, E, wid0); }
                else { pg8::EpiResid<false, false> E{P.x, P.ctx, XB, P.out, modl + 2 * DM, nullptr}; pg8::gemm_phase(lds, g, S, E, wid0); }
            }
        } else if (kind == 1) {
            REPEAT(REP_NORM) { pool_phase(H, POOLED, G, bid, wid0); GSYNC(); }
            {
                pg8::Gemm g{POOLED, WP, DM, 256, 256, 0, 1}; pg8::Sched S; S.init(256, 4, G, bid, 256, 0, 0);
                pg8::EpiResid<false, false> E{P.x, P.ctx, XB, P.out, modl + 2 * DM, P.pool_scale + slot * DM};
                pg8::gemm_phase(lds, g, S, E, wid0);
            }
        } else {
#pragma unroll 1
            for (int hb = 0; hb < 2; ++hb) {
                const int s0b = hb * 128, s1b = 256 + hb * 4;
                REPEAT(REP_GRQKV) {
                    pg8::Gemm g{H, WIN, DM, DM, DM, 0, 0}; pg8::Sched S; S.init(132, 16, G, bid, 128, s0b, s1b);
                    pg8::EpiRetQKV E{RQ, RV, ROPER_C, ROPER_S, SS};
                    pg8::gemm_phase(lds, g, S, E, wid0);
                    GSYNC();
                }
                {
                    ret_scan_phase(lds, RQ, RV, YF, YB, SS, (unsigned*)(ws + WS_CTL), hb, G, bid, wid0);
                    GSYNC();
                }
                REPEAT(REP_GGATE) {
                    pg8::Gemm g{H, WIN + (size_t)4096 * DM, DM, DM, DM, 0, 0}; pg8::Sched S; S.init(132, 16, G, bid, 128, s0b, s1b);
                    pg8::EpiRetGate E{YF, YB, SS, Z};
                    pg8::gemm_phase(lds, g, S, E, wid0);
                    GSYNC();
                }
                {
                    pg8::Gemm g{Z, WRO, 2048, 2048, 2048, 1, 0}; pg8::Sched S; S.init(132, 4, G, bid, 128, s0b, s1b);
                    pg8::EpiResid<false, false> E{P.x, P.ctx, XB, P.out, modl + 2 * DM, nullptr};
                    pg8::gemm_phase(lds, g, S, E, wid0);
                }
                if (hb == 0) GSYNC();
            }
        }
        GSYNC();
        if (kind != 2 && layer < 3) {
            const int nbc = G >= 64 ? 32 : G / 2;
            if (bid < nbc) {
                pg8::Sched S2; S2.init(8, 4, nbc, bid, 0, 0, 256);
                if (kind == 0) {
                    pg8::Gemm g{AO, WAO + (size_t)slot * DM * DM, DM, DM, DM, 0, 0};
                    if (layer == 0) { pg8::EpiResid<true, false> E{P.x, P.ctx, XB, P.out, modl + 2 * DM, nullptr}; pg8::gemm_phase(lds, g, S2, E, wid0); }
                    else { pg8::EpiResid<false, false> E{P.x, P.ctx, XB, P.out, modl + 2 * DM, nullptr}; pg8::gemm_phase(lds, g, S2, E, wid0); }
                } else {
                    pg8::Gemm g{POOLED, WP, DM, 256, 256, 0, 1};
                    pg8::EpiResid<false, false> E{P.x, P.ctx, XB, P.out, modl + 2 * DM, P.pool_scale + slot * DM}; pg8::gemm_phase(lds, g, S2, E, wid0);
                }
            } else prenorm_phase<false>(P.x, P.ctx, XB, P.norm_ffn + layer * DM, modl, 3, 4, H, 0, MLAT, G - nbc, bid - nbc, wid0);
            GSYNC();
            prenorm_phase<false>(P.x, P.ctx, XB, P.norm_ffn + layer * DM, modl, 3, 4, H, MLAT, MTOT, G, bid, wid0); GSYNC();
        } else { prenorm_phase<false>(P.x, P.ctx, XB, P.norm_ffn + layer * DM, modl, 3, 4, H, 0, ntm * 256, G, bid, wid0); GSYNC(); }
        REPEAT(REP_GGU) {
            pg8::Gemm g{H, WGU + (size_t)layer * 5632 * DM, DM, DM, DM, 0, 0}; pg8::Sched S; S.init(ntm, 22, G, bid, ntm, 0, 0);
            pg8::EpiSwiGLU E{HID};
            pg8::gemm_phase(lds, g, S, E, wid0);
            GSYNC();
        }
        {
            pg8::Gemm g{HID, WD + (size_t)layer * DM * FFH, FFH, FFH, FFH, 0, 0};
            if (layer == 3) {
                pg8::Sched S; S.init(256, 4, G, bid, 256, 0, 0);
                pg8::EpiResid<false, true> E{P.x, P.ctx, XB, P.out, modl + 5 * DM, nullptr}; pg8::gemm_phase(lds, g, S, E, wid0);
                GSYNC();
            } else {
                pg8::EpiResid<false, false> E{P.x, P.ctx, XB, P.out, modl + 5 * DM, nullptr};
                { pg8::Sched S; S.init(256, 4, G, bid, 256, 0, 0); pg8::gemm_phase(lds, g, S, E, wid0); }
                GSYNC();
                const int nbc = G >= 64 ? 32 : G / 2;
                const float* modn = modl + 9 * MODW; const float* gn = P.norm_mix + (layer + 1) * DM;
                if (bid < nbc) { pg8::Sched S; S.init(8, 4, nbc, bid, 0, 0, 256); pg8::gemm_phase(lds, g, S, E, wid0); }
                else prenorm_phase<false>(P.x, P.ctx, XB, gn, modn, 0, 1, H, 0, MLAT, G - nbc, bid - nbc, wid0);
                GSYNC();
                prenorm_phase<false>(P.x, P.ctx, XB, gn, modn, 0, 1, H, MLAT, MTOT, G, bid, wid0);
                GSYNC();
            }
        }
        REPEAT(REP_SYNC) GSYNC();
    }
}

extern "C" void kernel_launch(void* const* d_in, const int* in_sizes, int n_in, void* d_out, int out_size, void* d_ws, size_t ws_size, hipStream_t stream) {
    static int grid_blocks = 0;
    if (grid_blocks == 0) {
        if (n_in != 20 || ws_size < WS_END) { fprintf(stderr, "kernel_launch: unexpected inputs (n_in %d, ws %zu)\n", n_in, ws_size); grid_blocks = -1; return; }
        int dev = 0, cus = 0, per_cu = 0;
        hipGetDevice(&dev);
        hipDeviceGetAttribute(&cus, hipDeviceAttributeMultiprocessorCount, dev);
        if (hipFuncSetAttribute((const void*)fwd_megakernel, hipFuncAttributeMaxDynamicSharedMemorySize, LDS_BYTES) != hipSuccess) { fprintf(stderr, "kernel_launch: hipFuncSetAttribute failed\n"); grid_blocks = -1; return; }
        if (hipOccupancyMaxActiveBlocksPerMultiprocessor(&per_cu, (const void*)fwd_megakernel, 512, LDS_BYTES) != hipSuccess || per_cu < 1) { fprintf(stderr, "kernel_launch: occupancy query failed (%d)\n", per_cu); per_cu = 1; (void)hipGetLastError(); }
        grid_blocks = cus * per_cu;
    }
    if (grid_blocks < 0) return;
    Params p{};
    p.x = (const float*)d_in[0]; p.c = (const float*)d_in[1]; p.ctx = (const float*)d_in[2]; p.c_ctx = (const float*)d_in[3]; p.ada_w = (const float*)d_in[4]; p.ada_b = (const float*)d_in[5];
    p.norm_mix = (const float*)d_in[6]; p.norm_ffn = (const float*)d_in[7]; p.attn_w_qkv = (const float*)d_in[8]; p.attn_w_o = (const float*)d_in[9]; p.attn_q_norm = (const float*)d_in[10];
    p.attn_k_norm = (const float*)d_in[11]; p.attn_sink = (const float*)d_in[12]; p.pool_w = (const float*)d_in[13]; p.pool_scale = (const float*)d_in[14]; p.ret_w_in = (const float*)d_in[15];
    p.ret_w_o = (const float*)d_in[16]; p.ffn_w_gate = (const float*)d_in[17]; p.ffn_w_up = (const float*)d_in[18]; p.ffn_w_down = (const float*)d_in[19];
    p.out = (float*)d_out; p.ws = (unsigned char*)d_ws;
    if (hipMemsetAsync((char*)d_ws + WS_CTL, 0, 32768, stream) != hipSuccess) { fprintf(stderr, "kernel_launch: memset failed\n"); return; }
    void* args[] = {&p};
    hipError_t e = hipLaunchCooperativeKernel((const void*)fwd_megakernel, dim3(grid_blocks), dim3(512), args, LDS_BYTES, stream);
    if (e != hipSuccess) fprintf(stderr, "cooperative launch failed: %s (grid %d)\n", hipGetErrorString(e), grid_blocks);
}
```
